# Optimizing an MI355X kernel written in HIP

```python
import jax, jax.numpy as jnp
from jax import lax
import numpy as np

D_MODEL = 1024
BATCH = 2
SEQ = 8192
DEPTH = 1

N_META = 16
BLOCK = 128
PAD = BLOCK - N_META
MLA_HEADS = 8
MLA_NOPE = 64
MLA_ROPE = 32
MLA_V = 64
Q_LORA = 512
KV_LORA = 256
ROPE_THETA = 10000.0
FOX_HEADS = 8
FOX_HD = 64
N_GROUPS = 4
EXPERTS_PER_GROUP = 8
TOP_K = 2
D_EXPERT = 256
EPS = 1e-6
NEG = -1e30
IN_SPLITS = (Q_LORA, KV_LORA, MLA_ROPE, FOX_HEADS * FOX_HD, FOX_HEADS * FOX_HD, FOX_HEADS * FOX_HD, FOX_HEADS, D_MODEL, D_MODEL)
D_IN = sum(IN_SPLITS)

kernel_name = "hybrid_mla_fox_hmoe_block"


def rms_norm(x, g):
    xf = x.astype(jnp.float32)
    y = xf * lax.rsqrt(jnp.mean(xf * xf, axis=-1, keepdims=True) + EPS)
    return (y * g.astype(jnp.float32)).astype(x.dtype)


def rope_tables(length):
    pos = jnp.arange(length, dtype=jnp.float32)
    inv = ROPE_THETA ** (-jnp.arange(0, MLA_ROPE, 2, dtype=jnp.float32) / MLA_ROPE)
    ang = pos[:, None] * inv[None, :]
    return jnp.cos(ang), jnp.sin(ang)


def apply_rope(x, cos, sin):
    xf = x.astype(jnp.float32)
    x1, x2 = xf[..., : MLA_ROPE // 2], xf[..., MLA_ROPE // 2:]
    c, s = cos[None, :, None, :], sin[None, :, None, :]
    return jnp.concatenate([x1 * c - x2 * s, x1 * s + x2 * c], axis=-1).astype(x.dtype)


def blocked_causal_attention(q, k, v, decay, scale):
    B, L, H, _ = q.shape
    dv = v.shape[-1]
    lp = L + PAD
    nb = lp // BLOCK

    def prep(t):
        return jnp.pad(t, ((0, 0), (PAD, 0)) + ((0, 0),) * (t.ndim - 2)).swapaxes(1, 2)

    qp = prep(q.astype(jnp.float32)) * scale
    kp = prep(k.astype(jnp.float32))
    vp = prep(v)
    q_blocks = qp.reshape(B, H, nb, BLOCK, -1).transpose(2, 0, 1, 3, 4)
    if decay is None:
        cp, c_blocks = None, None
    else:
        cp = prep(decay.astype(jnp.float32))
        c_blocks = cp.reshape(B, H, nb, BLOCK).transpose(2, 0, 1, 3)
    k_pos = jnp.arange(lp)
    k_valid = k_pos >= PAD

    def attend(args):
        i, qb, cb = args
        s = jnp.einsum('bhqd,bhkd->bhqk', qb, kp)
        if cp is not None:
            s = s + cb[..., :, None] - cp[:, :, None, :]
        q_pos = i * BLOCK + jnp.arange(BLOCK)
        mask = (k_pos[None, :] <= q_pos[:, None]) & k_valid[None, :]
        s = jnp.where(mask[None, None], s, NEG)
        p = jax.nn.softmax(s, axis=-1)
        return jnp.einsum('bhqk,bhkd->bhqd', p.astype(vp.dtype), vp)

    out = lax.map(attend, (jnp.arange(nb), q_blocks, c_blocks))
    out = out.transpose(1, 0, 3, 2, 4).reshape(B, lp, H * dv)
    return out[:, PAD:]


def mixer_block(u, cos, sin, w_in, b_forget, q_a_norm, w_q_up, kv_a_norm, w_kv_up,
                w_mla_out, w_fox_out, w_out):
    B, L, _ = u.shape
    proj = u @ w_in
    offsets = [int(o) for o in np.cumsum(IN_SPLITS)[:-1]]
    c_q, c_kv, k_r, fq, fk, fv, f_logit, g_a, g_b = jnp.split(proj, offsets, axis=-1)

    q = (rms_norm(c_q, q_a_norm) @ w_q_up).reshape(B, L, MLA_HEADS, MLA_NOPE + MLA_ROPE)
    q_mla = jnp.concatenate([q[..., :MLA_NOPE], apply_rope(q[..., MLA_NOPE:], cos, sin)], axis=-1)
    kv = (rms_norm(c_kv, kv_a_norm) @ w_kv_up).reshape(B, L, MLA_HEADS, MLA_NOPE + MLA_V)
    k_rope = jnp.broadcast_to(apply_rope(k_r[:, :, None, :], cos, sin), (B, L, MLA_HEADS, MLA_ROPE))
    k_mla = jnp.concatenate([kv[..., :MLA_NOPE], k_rope], axis=-1)
    y_a = blocked_causal_attention(q_mla, k_mla, kv[..., MLA_NOPE:], None,
                                   (MLA_NOPE + MLA_ROPE) ** -0.5)

    log_f = jax.nn.log_sigmoid(f_logit.astype(jnp.float32) + b_forget.astype(jnp.float32))
    decay = jnp.cumsum(log_f, axis=1)
    y_b = blocked_causal_attention(fq.reshape(B, L, FOX_HEADS, FOX_HD),
                                   fk.reshape(B, L, FOX_HEADS, FOX_HD),
                                   fv.reshape(B, L, FOX_HEADS, FOX_HD), decay, FOX_HD ** -0.5)

    merged = jax.nn.sigmoid(g_a) * (y_a @ w_mla_out) + jax.nn.sigmoid(g_b) * (y_b @ w_fox_out)
    return merged @ w_out


def hier_moe(u, w_group_router, b_group_router, w_expert_router, b_expert_router,
             w_gate, w_up, w_down):
    B, L, D = u.shape
    t = u.reshape(B * L, D)
    g_prob = jax.nn.softmax((t @ w_group_router).astype(jnp.float32) + b_group_router.astype(jnp.float32), axis=-1)
    g_w, g_idx = lax.top_k(g_prob, 1)
    e_logits = ((t @ w_expert_router).astype(jnp.float32) + b_expert_router.astype(jnp.float32)).reshape(-1, N_GROUPS, EXPERTS_PER_GROUP)
    e_logits = jnp.take_along_axis(e_logits, g_idx[:, :, None], axis=1)[:, 0]
    e_w, e_idx = lax.top_k(jax.nn.softmax(e_logits, axis=-1), TOP_K)
    e_w = e_w / jnp.sum(e_w, axis=-1, keepdims=True)
    within = jnp.einsum('tk,tke->te', e_w, jax.nn.one_hot(e_idx, EXPERTS_PER_GROUP, dtype=jnp.float32))
    combine = ((g_w * jax.nn.one_hot(g_idx[:, 0], N_GROUPS, dtype=jnp.float32))[:, :, None]
               * within[:, None, :]).astype(u.dtype)
    y = jnp.zeros_like(t)
    for g in range(N_GROUPS):
        a = jnp.einsum('td,edf->tef', t, w_gate[g])
        b = jnp.einsum('td,edf->tef', t, w_up[g])
        hmid = jax.nn.silu(a) * b * combine[:, g, :, None]
        y = y + jnp.einsum('tef,efd->td', hmid, w_down[g])
    return y.reshape(B, L, D)


def setup_inputs(seed: int = 0) -> dict:
    key = jax.random.key(seed)
    ks = jax.random.split(key, 21)
    f32 = jnp.float32
    nrm = lambda k, shape, scale: jax.random.normal(k, shape, f32) * scale
    G, E, F, D = N_GROUPS, EXPERTS_PER_GROUP, D_EXPERT, D_MODEL
    return {
        "x": nrm(ks[0], (BATCH, SEQ, D), 1.0),
        "meta": nrm(ks[1], (N_META, D), 1.0),
        "attn_norm": 1.0 + nrm(ks[2], (DEPTH, D), 0.02),
        "w_in": nrm(ks[3], (DEPTH, D, D_IN), D ** -0.5),
        "b_forget": 2.0 + nrm(ks[4], (DEPTH, FOX_HEADS), 0.1),
        "q_a_norm": 1.0 + nrm(ks[5], (DEPTH, Q_LORA), 0.02),
        "w_q_up": nrm(ks[6], (DEPTH, Q_LORA, MLA_HEADS * (MLA_NOPE + MLA_ROPE)), Q_LORA ** -0.5),
        "kv_a_norm": 1.0 + nrm(ks[7], (DEPTH, KV_LORA), 0.02),
        "w_kv_up": nrm(ks[8], (DEPTH, KV_LORA, MLA_HEADS * (MLA_NOPE + MLA_V)), KV_LORA ** -0.5),
        "w_mla_out": nrm(ks[9], (DEPTH, MLA_HEADS * MLA_V, D), (MLA_HEADS * MLA_V) ** -0.5),
        "w_fox_out": nrm(ks[10], (DEPTH, FOX_HEADS * FOX_HD, D), (FOX_HEADS * FOX_HD) ** -0.5),
        "w_out": nrm(ks[11], (DEPTH, D, D), D ** -0.5),
        "ffn_norm": 1.0 + nrm(ks[12], (DEPTH, D), 0.02),
        "w_group_router": nrm(ks[13], (DEPTH, D, G), D ** -0.5),
        "b_group_router": nrm(ks[14], (DEPTH, G), 0.01),
        "w_expert_router": nrm(ks[15], (DEPTH, D, G * E), D ** -0.5),
        "b_expert_router": nrm(ks[16], (DEPTH, G * E), 0.01),
        "w_gate": nrm(ks[17], (DEPTH, G, E, D, F), D ** -0.5),
        "w_up": nrm(ks[18], (DEPTH, G, E, D, F), D ** -0.5),
        "w_down": nrm(ks[19], (DEPTH, G, E, F, D), F ** -0.5),
        "final_norm": 1.0 + nrm(ks[20], (D,), 0.02),
    }


def reference(x, meta, attn_norm, w_in, b_forget, q_a_norm, w_q_up, kv_a_norm, w_kv_up,
              w_mla_out, w_fox_out, w_out, ffn_norm, w_group_router, b_group_router,
              w_expert_router, b_expert_router, w_gate, w_up, w_down, final_norm):
    B = x.shape[0]
    h = jnp.concatenate([jnp.broadcast_to(meta[None].astype(x.dtype), (B, N_META, D_MODEL)), x], axis=1)
    cos, sin = rope_tables(h.shape[1])
    for l in range(DEPTH):
        h = h + mixer_block(rms_norm(h, attn_norm[l]), cos, sin, w_in[l], b_forget[l],
                            q_a_norm[l], w_q_up[l], kv_a_norm[l], w_kv_up[l],
                            w_mla_out[l], w_fox_out[l], w_out[l])
        h = h + hier_moe(rms_norm(h, ffn_norm[l]), w_group_router[l], b_group_router[l],
                         w_expert_router[l], b_expert_router[l], w_gate[l], w_up[l], w_down[l])
    h = rms_norm(h, final_norm)
    return h[:, N_META:]
```

```cpp
#include <hip/hip_runtime.h>
#include <cstdio>
#include <cstdint>
#include <cmath>

namespace nv {
constexpr int NB = 2, SEQ = 8192, D = 1024, NMETA = 16, L = SEQ + NMETA, T = NB * L, TR = NB * SEQ;
constexpr int QL = 512, KVL = 256, ROPE = 32, NOPE = 64, VD = 64, NH = 8, FH = 8, FD = 64;
constexpr int DIN = 4392;
constexpr int O_CQ = 0, O_CKV = 512, O_KR = 768, O_FQ = 800, O_FK = 1312, O_FV = 1824, O_FL = 2336, O_GA = 2344, O_GB = 3368;
constexpr int NG = 4, NE = 8, FE = 256;
constexpr float EPS = 1e-6f;

__device__ __forceinline__ float wave_sum(float v) {
#pragma unroll
    for (int o = 1; o < 64; o <<= 1) v += __shfl_xor(v, o);
    return v;
}
__device__ __forceinline__ const float* h0row(const float* x, const float* meta, int r) {
    const int b = r / L, p = r % L;
    return p < NMETA ? meta + (size_t)p * D : x + ((size_t)b * SEQ + (p - NMETA)) * D;
}
__device__ __forceinline__ int real2full(int m) { return m + NMETA * (m / SEQ + 1); }

template <int MODE>
__global__ void k_rstd(const float* x, const float* meta, const float* buf, int ld, int K, int rows, float* rs) {
    const int w = (blockIdx.x * blockDim.x + threadIdx.x) >> 6, lane = threadIdx.x & 63;
    if (w >= rows) return;
    const float* p = MODE == 0 ? h0row(x, meta, w) : buf + (size_t)w * ld;
    float s = 0.f;
    for (int k = lane; k < K; k += 64) { const float v = p[k]; s += v * v; }
    s = wave_sum(s);
    if (lane == 0) rs[w] = 1.0f / sqrtf(s / (float)K + EPS);
}

struct GemmArgs {
    const float* x; const float* meta;
    const float* A; int lda;
    const float* rs; const float* gk;
    const float* Bm; int ldb;
    float* C; int ldc;
    const float* G; int ldg;
    int M, N, K; int accumulate;
};
template <int ASRC, int EPI>
__global__ void __launch_bounds__(256) k_gemm(GemmArgs g) {
    __shared__ float As[16][68];
    __shared__ float Bs[16][68];
    const int tid = threadIdx.x, tx = tid & 15, ty = tid >> 4;
    const int m0 = blockIdx.y * 64, n0 = blockIdx.x * 64;
    float acc[4][4];
#pragma unroll
    for (int i = 0; i < 4; ++i)
#pragma unroll
        for (int j = 0; j < 4; ++j) acc[i][j] = 0.f;
    const int ar = tid >> 2, ak = (tid & 3) * 4;
    const int am = m0 + ar;
    const float* arow = nullptr; float ars = 0.f;
    if (am < g.M) {
        if (ASRC == 0) arow = g.A + (size_t)am * g.lda;
        else if (ASRC == 1) arow = h0row(g.x, g.meta, am);
        else if (ASRC == 2) arow = g.x + (size_t)am * D;
        else arow = g.A + (size_t)real2full(am) * g.lda;
        ars = g.rs ? g.rs[ASRC == 3 || ASRC == 2 ? am : am] : 1.f;
    }
    const int bk = tid >> 4, bn = (tid & 15) * 4;
    for (int k0 = 0; k0 < g.K; k0 += 16) {
        float a4[4] = {0.f, 0.f, 0.f, 0.f};
        if (arow) {
#pragma unroll
            for (int j = 0; j < 4; ++j) { float v = arow[k0 + ak + j] * ars; if (g.gk) v *= g.gk[k0 + ak + j]; a4[j] = v; }
        }
#pragma unroll
        for (int j = 0; j < 4; ++j) As[ak + j][ar] = a4[j];
#pragma unroll
        for (int j = 0; j < 4; ++j) { const int n = n0 + bn + j; Bs[bk][bn + j] = n < g.N ? g.Bm[(size_t)(k0 + bk) * g.ldb + n] : 0.f; }
        __syncthreads();
#pragma unroll
        for (int k = 0; k < 16; ++k) {
            float a[4], b[4];
#pragma unroll
            for (int i = 0; i < 4; ++i) a[i] = As[k][ty * 4 + i];
#pragma unroll
            for (int j = 0; j < 4; ++j) b[j] = Bs[k][tx * 4 + j];
#pragma unroll
            for (int i = 0; i < 4; ++i)
#pragma unroll
                for (int j = 0; j < 4; ++j) acc[i][j] = fmaf(a[i], b[j], acc[i][j]);
        }
        __syncthreads();
    }
#pragma unroll
    for (int i = 0; i < 4; ++i) {
        const int m = m0 + ty * 4 + i; if (m >= g.M) continue;
#pragma unroll
        for (int j = 0; j < 4; ++j) {
            const int n = n0 + tx * 4 + j; if (n >= g.N) continue;
            float v = acc[i][j];
            float* c = g.C + (size_t)m * g.ldc + n;
            if (EPI == 1) { const float gt = g.G[(size_t)m * g.ldg + n]; const float s = 1.f / (1.f + expf(-gt)); v = s * v + (g.accumulate ? *c : 0.f); }
            if (EPI == 2) v += g.x[(size_t)m * D + n];
            *c = v;
        }
    }
}

__global__ void k_rope_tab(float* ct, float* st) {
    const int i = blockIdx.x * blockDim.x + threadIdx.x; if (i >= L * 16) return;
    const int p = i / 16, j = i % 16;
    const double inv = pow(10000.0, -(double)(2 * j) / 32.0), ang = (double)p * inv;
    ct[i] = (float)cos(ang); st[i] = (float)sin(ang);
}
__global__ void k_rope(float* buf, int ld, int nheads, int stride, int off, const float* ct, const float* st) {
    const int i = blockIdx.x * blockDim.x + threadIdx.x; if (i >= T * nheads * 16) return;
    const int j = i % 16, h = (i / 16) % nheads, r = i / (16 * nheads), p = r % L;
    float* q = buf + (size_t)r * ld + h * stride + off;
    const float c = ct[p * 16 + j], s = st[p * 16 + j], x1 = q[j], x2 = q[j + 16];
    q[j] = x1 * c - x2 * s; q[j + 16] = x1 * s + x2 * c;
}
__global__ void k_decay(const float* fl, const float* bf, float* dec) {
    const int i = threadIdx.x; if (i >= NB * FH) return;
    const int b = i / FH, h = i % FH; double c = 0.0;
    for (int p = 0; p < L; ++p) {
        const int r = b * L + p; const double z = (double)fl[r * 8 + h] + (double)bf[h];
        const double ls = z >= 0 ? -log1p(exp(-z)) : z - log1p(exp(z));
        c += ls; dec[r * 8 + h] = (float)c;
    }
}

template <int DK, int KN, int DV, bool BIAS>
__global__ void __launch_bounds__(256) k_attn(const float* Qp, int ldq, int qstride, const float* Kp, int ldk, int kstride, const float* K2, int ldk2,
                                             const float* Vp, int ldv, int vstride, const float* dec, float scale, float* O, int ldo) {
    constexpr int DQ4 = DK / 4, DV4 = DV / 4;
    __shared__ float Ks[64][DK + 1];
    __shared__ float Vs[64][DV + 1];
    __shared__ float Cs[64];
    const int tid = threadIdx.x, ql = tid >> 2, part = tid & 3;
    const int bh = blockIdx.y, b = bh / NH, h = bh % NH;
    const int qp = blockIdx.x * 64 + ql;
    const bool qvalid = qp < L;
    const int qr = b * L + (qvalid ? qp : L - 1);
    float q[DQ4], o[DV4];
#pragma unroll
    for (int i = 0; i < DQ4; ++i) q[i] = Qp[(size_t)qr * ldq + h * qstride + part * DQ4 + i] * scale;
#pragma unroll
    for (int i = 0; i < DV4; ++i) o[i] = 0.f;
    float m = -INFINITY, l = 0.f;
    const float cq = BIAS ? dec[qr * 8 + h] : 0.f;
    const int nkt = blockIdx.x + 1;
    for (int kt = 0; kt < nkt; ++kt) {
        __syncthreads();
        for (int i = tid; i < 64 * DK; i += 256) { const int j = i / DK, d = i % DK; const int kp = kt * 64 + j; const int kr = b * L + (kp < L ? kp : L - 1);
            Ks[j][d] = d < KN ? Kp[(size_t)kr * ldk + h * kstride + d] : K2[(size_t)kr * ldk2 + (d - KN)]; }
        for (int i = tid; i < 64 * DV; i += 256) { const int j = i / DV, d = i % DV; const int kp = kt * 64 + j; const int kr = b * L + (kp < L ? kp : L - 1);
            Vs[j][d] = Vp[(size_t)kr * ldv + h * vstride + d]; }
        if (BIAS && tid < 64) { const int kp = kt * 64 + tid; const int kr = b * L + (kp < L ? kp : L - 1); Cs[tid] = dec[kr * 8 + h]; }
        __syncthreads();
        for (int j = 0; j < 64; ++j) {
            const int kp = kt * 64 + j;
            float s = 0.f;
#pragma unroll
            for (int i = 0; i < DQ4; ++i) s = fmaf(q[i], Ks[j][part * DQ4 + i], s);
            s += __shfl_xor(s, 1); s += __shfl_xor(s, 2);
            if (BIAS) s += cq - Cs[j];
            if (kp > qp || kp >= L) continue;
            const float mn = fmaxf(m, s), f = expf(m - mn), p = expf(s - mn);
            l = l * f + p; m = mn;
#pragma unroll
            for (int i = 0; i < DV4; ++i) o[i] = o[i] * f + p * Vs[j][part * DV4 + i];
        }
    }
    if (qvalid) {
        const float il = 1.f / l;
#pragma unroll
        for (int i = 0; i < DV4; ++i) O[(size_t)qr * ldo + h * DV + part * DV4 + i] = o[i] * il;
    }
}

__global__ void k_route(const float* H1, const float* gnorm, const float* wgr, const float* bgr, const float* wer, const float* ber, float* rs, int* ridx, float* rw) {
    const int w = (blockIdx.x * blockDim.x + threadIdx.x) >> 6, lane = threadIdx.x & 63;
    if (w >= TR) return;
    const float* hp = H1 + (size_t)w * D;
    float s = 0.f;
    for (int k = lane; k < D; k += 64) { const float v = hp[k]; s += v * v; }
    s = wave_sum(s);
    const float r = 1.0f / sqrtf(s / (float)D + EPS);
    float lg[36];
#pragma unroll
    for (int j = 0; j < 36; ++j) lg[j] = 0.f;
    for (int k = lane; k < D; k += 64) {
        const float t = hp[k] * r * gnorm[k];
#pragma unroll
        for (int j = 0; j < 4; ++j) lg[j] = fmaf(t, wgr[k * 4 + j], lg[j]);
#pragma unroll
        for (int j = 0; j < 32; ++j) lg[4 + j] = fmaf(t, wer[k * 32 + j], lg[4 + j]);
    }
#pragma unroll
    for (int j = 0; j < 36; ++j) lg[j] = wave_sum(lg[j]);
    if (lane == 0) {
        float gl[4]; float gm = -INFINITY; int gi = 0;
#pragma unroll
        for (int j = 0; j < 4; ++j) { gl[j] = lg[j] + bgr[j]; if (gl[j] > gm) { gm = gl[j]; gi = j; } }
        float gs = 0.f;
#pragma unroll
        for (int j = 0; j < 4; ++j) gs += expf(gl[j] - gm);
        const float gw = 1.f / gs;
        float el[8]; float em = -INFINITY;
#pragma unroll
        for (int j = 0; j < 8; ++j) {
            float v = 0.f;
#pragma unroll
            for (int gg = 0; gg < 4; ++gg) if (gg == gi) v = lg[4 + gg * 8 + j] + ber[gg * 8 + j];
            el[j] = v; em = fmaxf(em, v);
        }
        int i0 = 0; float v0 = -INFINITY;
#pragma unroll
        for (int j = 0; j < 8; ++j) if (el[j] > v0) { v0 = el[j]; i0 = j; }
        int i1 = 0; float v1 = -INFINITY;
#pragma unroll
        for (int j = 0; j < 8; ++j) if (j != i0 && el[j] > v1) { v1 = el[j]; i1 = j; }
        const float p0 = expf(v0 - em), p1 = expf(v1 - em), ps = p0 + p1;
        rs[w] = r; ridx[w * 2] = gi * 8 + i0; ridx[w * 2 + 1] = gi * 8 + i1; rw[w * 2] = gw * p0 / ps; rw[w * 2 + 1] = gw * p1 / ps;
    }
}
__global__ void __launch_bounds__(256) k_moe_final(const float* H1, const float* gnorm, const float* rs, const int* ridx, const float* rw,
                                                   const float* Wg, const float* Wu, const float* Wd, const float* fnorm, float* out) {
    __shared__ float ts[D];
    __shared__ float hm[FE];
    __shared__ float red[4];
    const int tok = blockIdx.x, tid = threadIdx.x;
    const float* hp = H1 + (size_t)tok * D; const float r = rs[tok];
    for (int k = tid; k < D; k += 256) ts[k] = hp[k] * r * gnorm[k];
    float y[4] = {0.f, 0.f, 0.f, 0.f};
    for (int kk = 0; kk < 2; ++kk) {
        const int e = ridx[tok * 2 + kk]; const float cw = rw[tok * 2 + kk];
        const float* wg = Wg + (size_t)e * D * FE; const float* wu = Wu + (size_t)e * D * FE; const float* wd = Wd + (size_t)e * FE * D;
        __syncthreads();
        float a = 0.f, bb = 0.f;
        for (int k = 0; k < D; ++k) { const float t = ts[k]; a = fmaf(t, wg[(size_t)k * FE + tid], a); bb = fmaf(t, wu[(size_t)k * FE + tid], bb); }
        hm[tid] = (a / (1.f + expf(-a))) * bb * cw;
        __syncthreads();
        for (int f = 0; f < FE; ++f) { const float hv = hm[f];
#pragma unroll
            for (int j = 0; j < 4; ++j) y[j] = fmaf(hv, wd[(size_t)f * D + tid + 256 * j], y[j]); }
    }
    float v[4], s = 0.f;
#pragma unroll
    for (int j = 0; j < 4; ++j) { v[j] = hp[tid + 256 * j] + y[j]; s += v[j] * v[j]; }
    s = wave_sum(s);
    __syncthreads();
    if ((tid & 63) == 0) red[tid >> 6] = s;
    __syncthreads();
    const float tot = red[0] + red[1] + red[2] + red[3];
    const float rr = 1.0f / sqrtf(tot / (float)D + EPS);
#pragma unroll
    for (int j = 0; j < 4; ++j) out[(size_t)tok * D + tid + 256 * j] = v[j] * rr * fnorm[tid + 256 * j];
}
}

extern "C" void kernel_launch(void* const* d_in, const int* in_sizes, int n_in, void* d_out, int out_size, void* d_ws, size_t ws_size, hipStream_t stream) {
    using namespace nv;
    const float* x = (const float*)d_in[0]; const float* meta = (const float*)d_in[1]; const float* attn_norm = (const float*)d_in[2];
    const float* w_in = (const float*)d_in[3]; const float* b_forget = (const float*)d_in[4]; const float* q_a_norm = (const float*)d_in[5];
    const float* w_q_up = (const float*)d_in[6]; const float* kv_a_norm = (const float*)d_in[7]; const float* w_kv_up = (const float*)d_in[8];
    const float* w_mla_out = (const float*)d_in[9]; const float* w_fox_out = (const float*)d_in[10]; const float* w_out = (const float*)d_in[11];
    const float* ffn_norm = (const float*)d_in[12]; const float* w_gr = (const float*)d_in[13]; const float* b_gr = (const float*)d_in[14];
    const float* w_er = (const float*)d_in[15]; const float* b_er = (const float*)d_in[16]; const float* w_gate = (const float*)d_in[17];
    const float* w_up = (const float*)d_in[18]; const float* w_down = (const float*)d_in[19]; const float* final_norm = (const float*)d_in[20];
    float* out = (float*)d_out; char* ws = (char*)d_ws;
    constexpr size_t MiB = 1u << 20;
    float* RS0 = (float*)(ws + 0); float* RSQ = RS0 + T; float* RSKV = RSQ + T; float* RS1 = RSKV + T;
    float* CT = (float*)(ws + 1 * MiB); float* ST = CT + L * 16;
    float* DEC = (float*)(ws + 3 * MiB); float* FLb = DEC + T * 8;
    float* KR = (float*)(ws + 5 * MiB);
    int* RIDX = (int*)(ws + 8 * MiB); float* RW = (float*)(ws + 8 * MiB + 256 * 1024);
    float* CQ = (float*)(ws + 9 * MiB);
    float* CKV = (float*)(ws + 42 * MiB);
    float* FQ = (float*)(ws + 59 * MiB);
    float* FK = FQ + (size_t)T * 512; float* FV = FK + (size_t)T * 512;
    float* KVB = (float*)(ws + 156 * MiB);
    float* QB = out;
    float* YA = CQ; float* YB = KVB; float* G = FQ; float* MERGED = out; float* H1 = FQ;

    auto gemm_grid = [](int M, int N) { return dim3((N + 63) / 64, (M + 63) / 64); };
    GemmArgs g{};
    g.x = x; g.meta = meta;
    k_rstd<0><<<(T * 64 + 255) / 256, 256, 0, stream>>>(x, meta, nullptr, 0, D, T, RS0);
    auto proj = [&](int col0, int N, float* C, int ldc) {
        GemmArgs a = g; a.rs = RS0; a.gk = attn_norm; a.Bm = w_in + col0; a.ldb = DIN; a.C = C; a.ldc = ldc; a.M = T; a.N = N; a.K = D;
        k_gemm<1, 0><<<gemm_grid(T, N), 256, 0, stream>>>(a);
    };
    proj(O_CQ, 512, CQ, 512); proj(O_CKV, 256, CKV, 256); proj(O_KR, 32, KR, 32);
    proj(O_FQ, 512, FQ, 512); proj(O_FK, 512, FK, 512); proj(O_FV, 512, FV, 512); proj(O_FL, 8, FLb, 8);
    k_rstd<1><<<(T * 64 + 255) / 256, 256, 0, stream>>>(nullptr, nullptr, CQ, 512, 512, T, RSQ);
    k_rstd<1><<<(T * 64 + 255) / 256, 256, 0, stream>>>(nullptr, nullptr, CKV, 256, 256, T, RSKV);
    { GemmArgs a = g; a.A = CQ; a.lda = 512; a.rs = RSQ; a.gk = q_a_norm; a.Bm = w_q_up; a.ldb = 768; a.C = QB; a.ldc = 768; a.M = T; a.N = 768; a.K = 512;
      k_gemm<0, 0><<<gemm_grid(T, 768), 256, 0, stream>>>(a); }
    { GemmArgs a = g; a.A = CKV; a.lda = 256; a.rs = RSKV; a.gk = kv_a_norm; a.Bm = w_kv_up; a.ldb = 1024; a.C = KVB; a.ldc = 1024; a.M = T; a.N = 1024; a.K = 256;
      k_gemm<0, 0><<<gemm_grid(T, 1024), 256, 0, stream>>>(a); }
    k_rope_tab<<<(L * 16 + 255) / 256, 256, 0, stream>>>(CT, ST);
    k_rope<<<(T * 8 * 16 + 255) / 256, 256, 0, stream>>>(QB, 768, 8, 96, 64, CT, ST);
    k_rope<<<(T * 1 * 16 + 255) / 256, 256, 0, stream>>>(KR, 32, 1, 32, 0, CT, ST);
    k_decay<<<1, 64, 0, stream>>>(FLb, b_forget, DEC);
    const dim3 agrid((L + 63) / 64, NB * NH);
    k_attn<96, 64, 64, false><<<agrid, 256, 0, stream>>>(QB, 768, 96, KVB, 1024, 128, KR, 32, KVB + 64, 1024, 128, nullptr, 1.0f / sqrtf(96.f), YA, 512);
    k_attn<64, 64, 64, true><<<agrid, 256, 0, stream>>>(FQ, 512, 64, FK, 512, 64, nullptr, 0, FV, 512, 64, DEC, 0.125f, YB, 512);
    k_rstd<1><<<(TR * 64 + 255) / 256, 256, 0, stream>>>(nullptr, nullptr, x, D, D, TR, RS1);
    { GemmArgs a = g; a.rs = RS1; a.gk = attn_norm; a.Bm = w_in + O_GA; a.ldb = DIN; a.C = G; a.ldc = D; a.M = TR; a.N = D; a.K = D;
      k_gemm<2, 0><<<gemm_grid(TR, D), 256, 0, stream>>>(a); }
    { GemmArgs a = g; a.A = YA; a.lda = 512; a.Bm = w_mla_out; a.ldb = D; a.C = MERGED; a.ldc = D; a.G = G; a.ldg = D; a.M = TR; a.N = D; a.K = 512; a.accumulate = 0;
      k_gemm<3, 1><<<gemm_grid(TR, D), 256, 0, stream>>>(a); }
    { GemmArgs a = g; a.rs = RS1; a.gk = attn_norm; a.Bm = w_in + O_GB; a.ldb = DIN; a.C = G; a.ldc = D; a.M = TR; a.N = D; a.K = D;
      k_gemm<2, 0><<<gemm_grid(TR, D), 256, 0, stream>>>(a); }
    { GemmArgs a = g; a.A = YB; a.lda = 512; a.Bm = w_fox_out; a.ldb = D; a.C = MERGED; a.ldc = D; a.G = G; a.ldg = D; a.M = TR; a.N = D; a.K = 512; a.accumulate = 1;
      k_gemm<3, 1><<<gemm_grid(TR, D), 256, 0, stream>>>(a); }
    { GemmArgs a = g; a.A = MERGED; a.lda = D; a.Bm = w_out; a.ldb = D; a.C = H1; a.ldc = D; a.M = TR; a.N = D; a.K = D;
      k_gemm<0, 2><<<gemm_grid(TR, D), 256, 0, stream>>>(a); }
    k_route<<<(TR * 64 + 255) / 256, 256, 0, stream>>>(H1, ffn_norm, w_gr, b_gr, w_er, b_er, RS1, RIDX, RW);
    k_moe_final<<<TR, 256, 0, stream>>>(H1, ffn_norm, RS1, RIDX, RW, w_gate, w_up, w_down, final_norm, out);
}
```

```cpp
#include <hip/hip_runtime.h>
#include <cstdio>
#include <cstdint>
#include <cmath>
namespace pg8 {
#define PG8_LAS __attribute__((address_space(3)))
typedef unsigned short bf16_t;
typedef short bf16x8 __attribute__((ext_vector_type(8)));
typedef float f32x4 __attribute__((ext_vector_type(4)));
typedef unsigned u32x4 __attribute__((ext_vector_type(4)));
constexpr int BM = 256, BK = 64, HALF = 128, HTB = HALF * BK * 2  , STAGE_BYTES = 8 * HTB;

__host__ __device__ __forceinline__ int lds_byte(int r, int c) { const int st = (r >> 4) * 2 + (c >> 5), rr = r & 15, cc = c & 31, ob = rr * 64 + cc * 2; return st * 1024 + (ob ^ (((ob >> 9) & 1) << 5)); }
__host__ __device__ __forceinline__ void stage_rc(int b, int& R, int& C) { const int st = b / 1024, sb = b % 1024, swz = sb ^ (((sb >> 9) & 1) << 5); R = (st >> 1) * 16 + swz / 64; C = (st & 1) * 32 + (swz % 64) / 2; }
__host__ __device__ __forceinline__ int perm32(int rho) { const int n = rho >> 4, i = rho & 15; return 8 * (i >> 2) + 4 * n + (i & 3); }

struct Unit { int pm, pn, be; };
struct Gemm { const bf16_t* A; const bf16_t* Bt; int K, lda; const int* rowidx; size_t bstride; };

__device__ __forceinline__ unsigned cvt_pk_bf16(float lo, float hi) { unsigned r; asm volatile("v_cvt_pk_bf16_f32 %0, %1, %2" : "=v"(r) : "v"(lo), "v"(hi)); return r; }
__device__ __forceinline__ u32x4 pack8(const f32x4 v0, const f32x4 v1) { u32x4 w; w.x = cvt_pk_bf16(v0[0], v0[1]); w.y = cvt_pk_bf16(v0[2], v0[3]); w.z = cvt_pk_bf16(v1[0], v1[1]); w.w = cvt_pk_bf16(v1[2], v1[3]); return w; }

template <class Epi, class Sched, bool ALIGN_EPI>
__device__ __forceinline__ void gemm_phase(PG8_LAS unsigned char* lds, const Gemm g, const Sched& S, const Epi& E) {
    const int tid = threadIdx.x, wid = __builtin_amdgcn_readfirstlane(tid >> 6), lane = tid & 63, wr = wid >> 2, wc = wid & 3, fr = lane & 15, fq = lane >> 4;
    const int K = g.K, nt = K / BK;
    int sR[2], sC[2]; unsigned voffB[2];
#pragma unroll
    for (int i = 0; i < 2; ++i) { int R, C; stage_rc(tid * 16 + i * 8192, R, C); const int Rb = Epi::PERM ? ((R & ~31) + perm32(R & 31)) : R;
        sR[i] = R; sC[i] = C; voffB[i] = (unsigned)(Rb * K + C) * 2u; }
    const size_t kstep = (size_t)(BK * 2);
    const size_t hstepB = (size_t)HALF * K * 2;
    const size_t tstepB = 2 * hstepB;
    const unsigned ldsw = (unsigned)wid * 1024u;
    const int aoff = lds_byte(wr * 64 + fr, fq * 8), boff = lds_byte(wc * 32 + fr, fq * 8);
#define PG8_MKV(v, u) do { _Pragma("unroll") for (int _h = 0; _h < 2; ++_h) _Pragma("unroll") for (int _i = 0; _i < 2; ++_i) { \
        const int _tr = (u).pm * BM + _h * HALF + sR[_i]; const int _row = g.rowidx ? g.rowidx[_tr] : _tr; (v)[_h][_i] = ((unsigned)_row * (unsigned)g.lda + (unsigned)sC[_i]) * 2u; } } while (0)
#define PG8_SA(b, h) (((b) * 2 + (h)) * HTB)
#define PG8_SB(b, h) ((4 + (b) * 2 + (h)) * HTB)
#define PG8_STAGE(bufoff, gbase, voff) do { _Pragma("unroll") for (int _i = 0; _i < 2; ++_i) \
        __builtin_amdgcn_global_load_lds((const unsigned*)((const char*)(gbase) + (voff)[_i]), (PG8_LAS unsigned*)(lds + (bufoff) + ldsw + _i * 8192), 16, 0, 0); } while (0)
#define PG8_LDA(dst, b, h) do { _Pragma("unroll") for (int m = 0; m < 4; ++m) _Pragma("unroll") for (int k = 0; k < 2; ++k) dst[m][k] = *(const PG8_LAS bf16x8*)(lds + PG8_SA(b, h) + aoff + m * 2048 + k * 1024); } while (0)
#define PG8_LDB(dst, b, h) do { _Pragma("unroll") for (int n = 0; n < 2; ++n) _Pragma("unroll") for (int k = 0; k < 2; ++k) dst[n][k] = *(const PG8_LAS bf16x8*)(lds + PG8_SB(b, h) + boff + n * 2048 + k * 1024); } while (0)
#define PG8_MMA(ai, bj, At, Bt) do { __builtin_amdgcn_s_setprio(1); _Pragma("unroll") for (int m = 0; m < 4; ++m) _Pragma("unroll") for (int n = 0; n < 2; ++n) _Pragma("unroll") for (int k = 0; k < 2; ++k) \
        acc[ai][bj][m][n] = __builtin_amdgcn_mfma_f32_16x16x32_bf16(Bt[n][k], At[m][k], acc[ai][bj][m][n], 0, 0, 0); __builtin_amdgcn_s_setprio(0); } while (0)
#define PG8_WAIT_V(n) asm volatile("s_waitcnt vmcnt(" #n ")" ::: "memory")
#define PG8_WAIT_L(n) asm volatile("s_waitcnt lgkmcnt(" #n ")" ::: "memory")
#define PG8_BAR __builtin_amdgcn_s_barrier()
#define PG8_SCHED __builtin_amdgcn_sched_barrier(0)
    Unit cur, nxt; int ui = 0;
    if (!S.next(0, cur)) return;
    f32x4 acc[2][2][4][2];
#pragma unroll
    for (int a = 0; a < 2; ++a)
#pragma unroll
        for (int b = 0; b < 2; ++b)
#pragma unroll
            for (int m = 0; m < 4; ++m)
#pragma unroll
                for (int n = 0; n < 2; ++n) acc[a][b][m][n] = (f32x4){0.f, 0.f, 0.f, 0.f};
    bf16x8 At[4][2], B0[2][2], B1[2][2];
    unsigned vA[2][2], vN[2][2];
    PG8_MKV(vA, cur);
    const char* const pA = (const char*)g.A;
    const char* cB = (const char*)g.Bt + (size_t)cur.be * g.bstride + (size_t)cur.pn * tstepB;
    PG8_STAGE(PG8_SB(0, 0), cB, voffB); PG8_STAGE(PG8_SB(0, 1), cB + hstepB, voffB); PG8_STAGE(PG8_SA(0, 0), pA, vA[0]); PG8_STAGE(PG8_SA(0, 1), pA, vA[1]);
    if (wr == 1) PG8_BAR;
    PG8_WAIT_V(2); PG8_BAR;
    PG8_STAGE(PG8_SB(1, 0), cB + kstep, voffB); PG8_STAGE(PG8_SA(1, 0), pA + kstep, vA[0]); PG8_STAGE(PG8_SB(1, 1), cB + hstepB + kstep, voffB);
    PG8_WAIT_V(6); PG8_BAR;
    for (;;) {
        const bool has_next = S.next(ui + 1, nxt);
        if (has_next) PG8_MKV(vN, nxt);
        else {
#pragma unroll
            for (int h = 0; h < 2; ++h)
#pragma unroll
                for (int i = 0; i < 2; ++i) vN[h][i] = vA[h][i];
        }
        const char* nB = has_next ? (const char*)g.Bt + (size_t)nxt.be * g.bstride + (size_t)nxt.pn * tstepB : cB;
        for (int t = 0; t < nt; t += 2) {
            const bool last = (t == nt - 2);
            const char* a1 = pA + (size_t)(t + 1) * kstep;
            const char* a2 = last ? pA : pA + (size_t)(t + 2) * kstep; const char* b2 = last ? nB : cB + (size_t)(t + 2) * kstep;
            const char* a3 = a2 + kstep; const char* b3 = b2 + kstep;
            unsigned w0[2], w1[2];
#pragma unroll
            for (int i = 0; i < 2; ++i) { w0[i] = last ? vN[0][i] : vA[0][i]; w1[i] = last ? vN[1][i] : vA[1][i]; }
            PG8_LDB(B0, 0, 0); PG8_LDB(B1, 0, 1); PG8_SCHED; PG8_LDA(At, 0, 0); PG8_STAGE(PG8_SA(1, 1), a1, vA[1]);
            PG8_WAIT_V(8); PG8_WAIT_L(0); PG8_BAR; PG8_MMA(0, 0, At, B0); PG8_MMA(0, 1, At, B1); PG8_BAR; PG8_SCHED;
            PG8_LDA(At, 0, 1); PG8_STAGE(PG8_SB(0, 0), b2, voffB); PG8_STAGE(PG8_SB(0, 1), b2 + hstepB, voffB); PG8_STAGE(PG8_SA(0, 0), a2, w0);
            PG8_WAIT_V(8); PG8_WAIT_L(0); PG8_BAR; PG8_MMA(1, 0, At, B0); PG8_MMA(1, 1, At, B1); PG8_BAR; PG8_SCHED;
            PG8_LDB(B0, 1, 0); PG8_LDB(B1, 1, 1); PG8_SCHED; PG8_LDA(At, 1, 0); PG8_STAGE(PG8_SA(0, 1), a2, w1);
            PG8_WAIT_V(8); PG8_WAIT_L(0); PG8_BAR; PG8_MMA(0, 0, At, B0); PG8_MMA(0, 1, At, B1); PG8_BAR; PG8_SCHED;
            PG8_LDA(At, 1, 1); PG8_STAGE(PG8_SB(1, 0), b3, voffB); PG8_STAGE(PG8_SB(1, 1), b3 + hstepB, voffB); PG8_STAGE(PG8_SA(1, 0), a3, w0);
            PG8_WAIT_V(8); PG8_WAIT_L(0); PG8_BAR; PG8_MMA(1, 0, At, B0); PG8_MMA(1, 1, At, B1); PG8_BAR; PG8_SCHED;
        }
        if constexpr (ALIGN_EPI) { if (wr == 0) PG8_BAR; }
        E(acc, cur, wr, wc, fr, fq);
        if (!has_next) break;
#pragma unroll
        for (int a = 0; a < 2; ++a)
#pragma unroll
            for (int b = 0; b < 2; ++b)
#pragma unroll
                for (int m = 0; m < 4; ++m)
#pragma unroll
                    for (int n = 0; n < 2; ++n) acc[a][b][m][n] = (f32x4){0.f, 0.f, 0.f, 0.f};
        cur = nxt; cB = nB; ++ui;
#pragma unroll
        for (int h = 0; h < 2; ++h)
#pragma unroll
            for (int i = 0; i < 2; ++i) vA[h][i] = vN[h][i];
        if constexpr (ALIGN_EPI) { if (wr == 1) PG8_BAR; }
    }
    PG8_WAIT_V(0);
    if constexpr (!ALIGN_EPI) { if (wr == 0) PG8_BAR; }
    PG8_BAR;
#undef PG8_MKV
#undef PG8_SA
#undef PG8_SB
#undef PG8_STAGE
#undef PG8_LDA
#undef PG8_LDB
#undef PG8_MMA
#undef PG8_WAIT_V
#undef PG8_WAIT_L
#undef PG8_BAR
#undef PG8_SCHED
}
}

#define GAS __attribute__((address_space(1)))
#define LAS __attribute__((address_space(3)))
#define XB_TMO      128
#define XB_XCNT(j)  (256  + 64 * (j))
#define XB_XSUB(j)  (1280 + 64 * (j))
#define XB_XGEN(j)  (2304 + 64 * (j))
#define XB_TOP      3328
#define XB_TOPGEN   3392
#define XCD_BAR_WORDS 3456
#define XB_SPIN_CAP (1u << 18)

__device__ __forceinline__ unsigned xb_ld(unsigned* p)              { return __hip_atomic_load(p, __ATOMIC_RELAXED, __HIP_MEMORY_SCOPE_AGENT); }
__device__ __forceinline__ unsigned xb_add(unsigned* p, unsigned v) { return __hip_atomic_fetch_add(p, v, __ATOMIC_RELAXED, __HIP_MEMORY_SCOPE_AGENT); }
__device__ __forceinline__ unsigned xb_xcc_id() { return (unsigned)__builtin_amdgcn_s_getreg((3 << 11) | 20) & 0xFu; }
#define XB_SPIN(cond, bar) do { unsigned _sp = 0; while (cond) { __builtin_amdgcn_s_sleep(1); \
    if ((++_sp & 255u) == 0u) { if (xb_ld(&(bar)[XB_TMO])) break; if (_sp > XB_SPIN_CAP) { atomicAdd(&(bar)[XB_TMO], 1u); break; } } } } while (0)

struct XcdBarrier { unsigned* bar; unsigned x; volatile LAS unsigned* st; };

__device__ __forceinline__ XcdBarrier xcd_barrier_post(unsigned* bar, volatile LAS unsigned* st) {
    XcdBarrier b; b.bar = bar; b.x = xb_xcc_id(); b.st = st;
    if (threadIdx.x == 0) (void)xb_add(&bar[XB_XCNT(b.x)], 1u);
    return b;
}
__device__ __forceinline__ void xcd_barrier_complete(unsigned* bar, unsigned x, unsigned& nloc, unsigned& nx) {
    const unsigned G = gridDim.x * gridDim.y * gridDim.z;
    unsigned sum, cnt, mine, sp = 0u;
    for (;;) {
        sum = 0u; cnt = 0u; mine = 0u;
#pragma unroll
        for (unsigned j = 0; j < 16; ++j) { const unsigned c = xb_ld(&bar[XB_XCNT(j)]); sum += c; cnt += (c > 0u) ? 1u : 0u; mine = (j == x) ? c : mine; }
        if (sum == G) break;
        __builtin_amdgcn_s_sleep(1);
        if ((++sp & 255u) == 0u) { if (xb_ld(&bar[XB_TMO])) break; if (sp > XB_SPIN_CAP) { atomicAdd(&bar[XB_TMO], 1u); break; } }
    }
    nloc = mine > 0u ? mine : 1u; nx = cnt > 0u ? cnt : 1u;
}
__device__ __forceinline__ void xcd_barrier(const XcdBarrier& b) {
    asm volatile("s_waitcnt vmcnt(0)" ::: "memory");
    __syncthreads();
    if (threadIdx.x == 0) {
        unsigned* bar = b.bar;
        __builtin_amdgcn_s_waitcnt(0);
        unsigned nloc = b.st[0], nx = b.st[1];
        if (nloc == 0u) { xcd_barrier_complete(bar, b.x, nloc, nx); b.st[0] = nloc; b.st[1] = nx; }
        const unsigned old = xb_add(&bar[XB_XSUB(b.x)], 1u);
        const unsigned gen = old / nloc;
        if (old + 1u == (gen + 1u) * nloc) {
            __builtin_amdgcn_fence(__ATOMIC_RELEASE, "agent");
            asm volatile("s_waitcnt vmcnt(0)" ::: "memory");
            const unsigned og = xb_add(&bar[XB_TOP], 1u);
            const unsigned tg = og / nx;
            if (og + 1u == (tg + 1u) * nx) xb_add(&bar[XB_TOPGEN], 1u);
            else XB_SPIN(xb_ld(&bar[XB_TOPGEN]) == tg, bar);
            __builtin_amdgcn_fence(__ATOMIC_ACQUIRE, "agent");
            xb_add(&bar[XB_XGEN(b.x)], 1u);
            asm volatile("s_waitcnt vmcnt(0)" ::: "memory");
        } else {
            XB_SPIN(xb_ld(&bar[XB_XGEN(b.x)]) == gen, bar);
            __builtin_amdgcn_fence(__ATOMIC_ACQUIRE, "agent");
            asm volatile("s_waitcnt vmcnt(0)" ::: "memory");
        }
    }
    __syncthreads();
}

constexpr int NWAVES = 8;
constexpr int NB = 2, SEQ = 8192, DM = 1024, NMETA = 16, LSEQ = SEQ + NMETA;
constexpr int TR = NB * SEQ;
constexpr int MROWS = TR + 256;
constexpr int LP = 64 + SEQ;
constexpr int ARROWS = NB * LP;
constexpr int DIN = 4392, NIN = 4608;
constexpr int NEXP = 32, FE = 256;
constexpr float EPSN = 1e-6f;
constexpr float LOG2E = 1.4426950408889634f;
constexpr float QS_MLA = 0.10206207261596575f * LOG2E;
constexpr float QS_FOX = 0.125f * LOG2E;
constexpr float BIG = 1e30f;

constexpr size_t MiB = 1u << 20;
constexpr size_t WS_CTL = 0, CTL_ZERO_BYTES = 1 * MiB;
constexpr size_t WS_SSQQ = 1 * MiB, WS_SSQKV = 1 * MiB + 512 * 1024;
constexpr size_t WS_COS = 2 * MiB, WS_SIN = 3 * MiB, WS_FL = 4 * MiB, WS_CB = 5 * MiB, WS_BIAS0 = 5 * MiB + 768 * 1024, WS_KR = 6 * MiB, WS_RT = 9 * MiB;
constexpr size_t WS_WIN = 12 * MiB, WS_WQUP = 21 * MiB, WS_WKVUP = 22 * MiB, WS_WA = 23 * MiB, WS_WB = 24 * MiB, WS_WOUT = 25 * MiB, WS_WUP = 27 * MiB, WS_WD = 59 * MiB;
constexpr size_t WS_U = 75 * MiB, WS_CQ = 108 * MiB, WS_CKV = 125 * MiB, WS_FQ = 134 * MiB, WS_FK = 151 * MiB, WS_FV = 168 * MiB, WS_QM = 185 * MiB, WS_KM = 210 * MiB, WS_VM = 235 * MiB, WS_END = 252 * MiB;
constexpr size_t WS_Y = WS_U, WS_MERGED = 134 * MiB, WS_T = 166 * MiB, WS_HM = 108 * MiB, WS_YE = 128 * MiB;
static_assert(WS_U + (size_t)MROWS * DM * 2 <= WS_CQ && WS_CQ + (size_t)MROWS * 512 * 2 <= WS_CKV && WS_CKV + (size_t)MROWS * 256 * 2 <= WS_FQ, "ws map 1");
static_assert(WS_FQ + (size_t)ARROWS * 512 * 2 <= WS_FK && WS_FV + (size_t)ARROWS * 512 * 2 <= WS_QM && WS_QM + (size_t)ARROWS * 768 * 2 <= WS_KM && WS_KM + (size_t)ARROWS * 768 * 2 <= WS_VM && WS_VM + (size_t)ARROWS * 512 * 2 <= WS_END, "ws map 2");
static_assert(WS_WIN + (size_t)NIN * DM * 2 <= WS_WQUP && WS_WUP + (size_t)NEXP * 512 * 1024 * 2 <= WS_WD && WS_WD + (size_t)NEXP * 1024 * 256 * 2 <= WS_U, "ws map 3");
constexpr int CW_BAR = 4096;

constexpr int RING_OFF = 0, RING_BYTES = 131072, LDS_BYTES = 163840, LDSCTL_OFF = LDS_BYTES - 1024, MISC_OFF = LDSCTL_OFF + 320;

typedef unsigned short bf16;
typedef unsigned v4u __attribute__((ext_vector_type(4)));
typedef float f32x4 __attribute__((ext_vector_type(4)));
#define LDS_WAIT() asm volatile("s_waitcnt lgkmcnt(0)" ::: "memory")
#define VM_WAIT() asm volatile("s_waitcnt vmcnt(0)" ::: "memory")
__device__ __forceinline__ unsigned f2bf(float f) { unsigned u = __builtin_bit_cast(unsigned, f); return (u + 0x7fffu + ((u >> 16) & 1u)) >> 16; }
__device__ __forceinline__ unsigned pk2(float lo, float hi) { return f2bf(lo) | (f2bf(hi) << 16); }
__device__ __forceinline__ float bf2f(unsigned short v) { return __builtin_bit_cast(float, (unsigned)v << 16); }
__device__ __forceinline__ float wave_sum(float v) {
#pragma unroll
    for (int o = 1; o < 64; o <<= 1) v += __shfl_xor(v, o);
    return v;
}

struct Ptrs {
    const float* in[21]; float* out; unsigned char* ws; int ph_lo, ph_hi;
};
struct Frame {
    LAS unsigned char* lds; volatile LAS unsigned* MISC; unsigned* ctl;
    int tid, lane, wave, vcu, G;
};

__device__ __forceinline__ int srccol_in(int n) {
    if (n < 768) return n;
    if (n < 2304) return n + 32;
    if (n < 4352) return n + 40;
    if (n < 4384) { const int j = n - 4352, i = j >> 1; return 768 + ((j & 1) ? 16 + i : i); }
    if (n < 4392) return 2336 + (n - 4384);
    return -1;
}
__device__ __forceinline__ int srccol_q(int n) { const int h = n / 96, d = n % 96; if (d < 64) return n; const int j = d - 64, i = j >> 1; return h * 96 + 64 + ((j & 1) ? 16 + i : i); }

template <class Src>
__device__ __forceinline__ void transpose_item(const Src& src, int K, bf16* WT, LAS float* scr, int k0, int n0, int lane) {
#pragma unroll 8
    for (int i = 0; i < 32; ++i) { const int kk = 2 * i + (lane >> 5); scr[kk * 33 + (lane & 31)] = src(k0 + kk, n0 + (lane & 31)); }
    LDS_WAIT(); asm volatile("" ::: "memory");
    const int c = lane & 7;
#pragma unroll
    for (int j = 0; j < 4; ++j) { const int n = (lane >> 3) + 8 * j; const LAS float* s = scr + (8 * c) * 33 + n;
        v4u o; o.x = pk2(s[0 * 33], s[1 * 33]); o.y = pk2(s[2 * 33], s[3 * 33]); o.z = pk2(s[4 * 33], s[5 * 33]); o.w = pk2(s[6 * 33], s[7 * 33]);
        *(v4u*)(WT + (size_t)(n0 + n) * K + k0 + 8 * c) = o; }
    LDS_WAIT(); asm volatile("" ::: "memory");
}
struct SrcIn { const float* w; __device__ __forceinline__ float operator()(int k, int n) const { const int c = srccol_in(n); return c < 0 ? 0.f : w[(size_t)k * DIN + c]; } };
struct SrcQ { const float* w; const float* g; __device__ __forceinline__ float operator()(int k, int n) const { return g[k] * w[(size_t)k * 768 + srccol_q(n)]; } };
struct SrcKV { const float* w; const float* g; __device__ __forceinline__ float operator()(int k, int n) const { return g[k] * w[(size_t)k * 1024 + n]; } };
struct SrcPlain { const float* w; int N; __device__ __forceinline__ float operator()(int k, int n) const { return w[(size_t)k * N + n]; } };
struct SrcUp { const float* wg; long du; __device__ __forceinline__ float operator()(int k, int n) const { const int f = (n >> 8) * 128 + (n & 127); return (wg + (long)((n >> 7) & 1) * du)[(size_t)k * FE + f]; } };

__device__ __forceinline__ void p0_prologue(const Frame& F, const Ptrs& P) {
    LAS float* scr = (LAS float*)(F.lds + RING_OFF + F.wave * 16384);
    const int gw = F.vcu * NWAVES + F.wave, NGW = F.G * NWAVES, lane = F.lane;
    unsigned char* ws = P.ws;
    {
        const float* x = P.in[0]; const float* meta = P.in[1]; const float* g = P.in[2]; bf16* U = (bf16*)(ws + WS_U);
        f32x4 gv[4];
#pragma unroll
        for (int j = 0; j < 4; ++j) gv[j] = ((const f32x4*)g)[lane + 64 * j];
        for (int m = gw; m < MROWS; m += NGW) {
            unsigned long long* o8 = (unsigned long long*)(U + (size_t)m * DM) + lane;
            if (m >= TR + NMETA) {
#pragma unroll
                for (int j = 0; j < 4; ++j) o8[64 * j] = 0ull;
                continue; }
            const f32x4* xr = (const f32x4*)(m < TR ? x + (size_t)m * DM : meta + (size_t)(m - TR) * DM) + lane;
            f32x4 v[4]; float s = 0.f;
#pragma unroll
            for (int j = 0; j < 4; ++j) { v[j] = xr[64 * j]; s += (v[j].x * v[j].x + v[j].y * v[j].y) + (v[j].z * v[j].z + v[j].w * v[j].w); }
            const float rstd = 1.f / sqrtf(wave_sum(s) * (1.f / DM) + EPSN);
#pragma unroll
            for (int j = 0; j < 4; ++j) { const f32x4 w = v[j] * rstd * gv[j]; o8[64 * j] = (unsigned long long)pk2(w.x, w.y) | ((unsigned long long)pk2(w.z, w.w) << 32); }
        }
    }
    {
        constexpr int I_IN = (DM / 64) * (NIN / 32), I_Q = (512 / 64) * (768 / 32), I_KV = (256 / 64) * (1024 / 32), I_AB = (512 / 64) * (1024 / 32), I_O = (1024 / 64) * (1024 / 32);
        constexpr int I_UP1 = (1024 / 64) * (512 / 32), I_UP = NEXP * I_UP1, I_D1 = (256 / 64) * (1024 / 32), I_DN = NEXP * I_D1;
        constexpr int NITEMS = I_IN + I_Q + I_KV + 2 * I_AB + I_O + I_UP + I_DN;
        for (int it = gw; it < NITEMS; it += NGW) {
            int r = it;
            if (r < I_IN) { const int nb = NIN / 32; transpose_item(SrcIn{P.in[3]}, DM, (bf16*)(ws + WS_WIN), scr, 64 * (r / nb), 32 * (r % nb), lane); continue; } r -= I_IN;
            if (r < I_Q) { const int nb = 768 / 32; transpose_item(SrcQ{P.in[6], P.in[5]}, 512, (bf16*)(ws + WS_WQUP), scr, 64 * (r / nb), 32 * (r % nb), lane); continue; } r -= I_Q;
            if (r < I_KV) { const int nb = 1024 / 32; transpose_item(SrcKV{P.in[8], P.in[7]}, 256, (bf16*)(ws + WS_WKVUP), scr, 64 * (r / nb), 32 * (r % nb), lane); continue; } r -= I_KV;
            if (r < I_AB) { const int nb = 32; transpose_item(SrcPlain{P.in[9], 1024}, 512, (bf16*)(ws + WS_WA), scr, 64 * (r / nb), 32 * (r % nb), lane); continue; } r -= I_AB;
            if (r < I_AB) { const int nb = 32; transpose_item(SrcPlain{P.in[10], 1024}, 512, (bf16*)(ws + WS_WB), scr, 64 * (r / nb), 32 * (r % nb), lane); continue; } r -= I_AB;
            if (r < I_O) { const int nb = 32; transpose_item(SrcPlain{P.in[11], 1024}, 1024, (bf16*)(ws + WS_WOUT), scr, 64 * (r / nb), 32 * (r % nb), lane); continue; } r -= I_O;
            if (r < I_UP) { const int e = r / I_UP1, q = r % I_UP1, nb = 512 / 32;
                transpose_item(SrcUp{P.in[17] + (size_t)e * 1024 * FE, (long)(P.in[18] - P.in[17])}, 1024, (bf16*)(ws + WS_WUP) + (size_t)e * 512 * 1024, scr, 64 * (q / nb), 32 * (q % nb), lane); continue; } r -= I_UP;
            { const int e = r / I_D1, q = r % I_D1, nb = 1024 / 32;
                transpose_item(SrcPlain{P.in[19] + (size_t)e * FE * 1024, 1024}, 256, (bf16*)(ws + WS_WD) + (size_t)e * 1024 * 256, scr, 64 * (q / nb), 32 * (q % nb), lane); }
        }
    }
    {
        const int gt = F.vcu * (NWAVES * 64) + F.tid, NGT = F.G * NWAVES * 64;
        float* ct = (float*)(ws + WS_COS); float* st = (float*)(ws + WS_SIN);
        for (int i = gt; i < LSEQ * 16; i += NGT) { const int p = i >> 4, j = i & 15;
            const double ang = (double)p * pow(10000.0, -(double)j / 16.0);
            ct[i] = (float)cos(ang); st[i] = (float)sin(ang); }
        float* sq = (float*)(ws + WS_SSQQ); float* skv = (float*)(ws + WS_SSQKV);
        for (int i = gt; i < MROWS; i += NGT) { sq[i] = 0.f; skv[i] = 0.f; }
        float* b0 = (float*)(ws + WS_BIAS0);
        for (int i = gt; i < 64; i += NGT) b0[i] = i < NMETA ? 0.f : BIG;
        for (int i = gt; i < NB * 48 * (64 + 64 + 96 + 64); i += NGT) {
            const int per = 64 + 64 + 96 + 64, rr = i / per, c = i % per, b = rr / 48, row = b * LP + 16 + rr % 48;
            bf16* dst; if (c < 64) dst = (bf16*)(ws + WS_FK) + (size_t)row * 512 + c * 8; else if (c < 128) dst = (bf16*)(ws + WS_FV) + (size_t)row * 512 + (c - 64) * 8;
            else if (c < 224) dst = (bf16*)(ws + WS_KM) + (size_t)row * 768 + (c - 128) * 8; else dst = (bf16*)(ws + WS_VM) + (size_t)row * 512 + (c - 224) * 8;
            *(v4u*)dst = (v4u){0u, 0u, 0u, 0u}; }
    }
}

struct DenseOrder {
    int nM, nN, nwg, G, c;
    __device__ __forceinline__ void init(int nM_, int nN_, int G_, int c_) { nM = nM_; nN = nN_; nwg = nM * nN; G = G_; c = c_; }
    __device__ __forceinline__ bool next(int i, pg8::Unit& u) const {
        const long L = (long)i * G + c; if (L >= nwg) return false;
        int wgid = (int)L; { const int q = nwg / 8, r = nwg % 8, xcd = wgid % 8, off = wgid / 8; wgid = (xcd < r ? xcd * (q + 1) : r * (q + 1) + (xcd - r) * q) + off; }
        const int nig = 8 * nN, gid = wgid / nig, fm = gid * 8, gsz = (nM - fm) < 8 ? (nM - fm) : 8;
        u.pm = fm + ((wgid % nig) % gsz); u.pn = (wgid % nig) / gsz; u.be = 0; return true;
    }
};
__device__ __forceinline__ int arow_of(int m) { return (m >> 13) * LP + 64 + (m & (SEQ - 1)); }
__device__ __forceinline__ float sigmoid_fast(float x) { return __builtin_amdgcn_rcpf(1.f + __builtin_amdgcn_exp2f(-LOG2E * x)); }

struct EpiP1 {
    static constexpr bool PERM = true;
    unsigned char* ws; bf16* SG;
    __device__ __forceinline__ void operator()(const pg8::f32x4 (&acc)[2][2][4][2], const pg8::Unit& u, int wr, int wc, int fr, int fq) const {
        const int pn = u.pn;
#pragma unroll
        for (int ai = 0; ai < 2; ++ai)
#pragma unroll
            for (int m = 0; m < 4; ++m) {
                const int r = u.pm * 256 + ai * 128 + wr * 64 + m * 16 + fr;
                const int c8 = wc * 32 + 8 * fq;
                if (pn < 3) {
                    float s = 0.f;
                    const size_t off = pn < 2 ? WS_CQ + ((size_t)r * 512 + pn * 256 + c8) * 2 : WS_CKV + ((size_t)r * 256 + c8) * 2;
#pragma unroll
                    for (int bj = 0; bj < 2; ++bj) { const pg8::f32x4 v0 = acc[ai][bj][m][0], v1 = acc[ai][bj][m][1];
                        s += (v0[0] * v0[0] + v0[1] * v0[1]) + (v0[2] * v0[2] + v0[3] * v0[3]) + (v1[0] * v1[0] + v1[1] * v1[1]) + (v1[2] * v1[2] + v1[3] * v1[3]);
                        *(pg8::u32x4*)(ws + off + bj * 256) = pg8::pack8(v0, v1); }
                    s += __shfl_xor(s, 16); s += __shfl_xor(s, 32);
                    if (fq == 0) atomicAdd((float*)(ws + (pn < 2 ? WS_SSQQ : WS_SSQKV)) + r, s);
                } else if (pn < 9) {
                    const int seg = (pn - 3) >> 1, cb = ((pn - 3) & 1) * 256;
                    const float sc = seg == 0 ? QS_FOX : 1.f;
                    if (r < TR + NMETA) {
                        const int a0 = r < TR ? arow_of(r) : r - TR;
                        unsigned char* base = ws + WS_FQ + (size_t)seg * (WS_FK - WS_FQ) + ((size_t)a0 * 512 + cb + c8) * 2;
#pragma unroll
                        for (int bj = 0; bj < 2; ++bj) { const pg8::u32x4 w = pg8::pack8(acc[ai][bj][m][0] * sc, acc[ai][bj][m][1] * sc);
                            *(pg8::u32x4*)(base + bj * 256) = w;
                            if (r >= TR) *(pg8::u32x4*)(base + (size_t)LP * 1024 + bj * 256) = w; }
                    }
                } else if (pn < 17) {
                    if (r < TR) {
                        bf16* base = SG + (size_t)((pn - 9) >> 2) * TR * 1024 + (size_t)r * 1024 + ((pn - 9) & 3) * 256 + c8;
#pragma unroll
                        for (int bj = 0; bj < 2; ++bj) { pg8::f32x4 v0 = acc[ai][bj][m][0], v1 = acc[ai][bj][m][1];
#pragma unroll
                            for (int e = 0; e < 4; ++e) { v0[e] = sigmoid_fast(v0[e]); v1[e] = sigmoid_fast(v1[e]); }
                            *(pg8::u32x4*)(base + bj * 128) = pg8::pack8(v0, v1); }
                    }
                } else {
                    if (c8 < 32) { float* d = (float*)(ws + WS_KR) + (size_t)r * 32 + c8; *(pg8::f32x4*)d = acc[ai][0][m][0]; *(pg8::f32x4*)(d + 4) = acc[ai][0][m][1]; }
                    else if (c8 == 32) { float* d = (float*)(ws + WS_FL) + (size_t)r * 8; *(pg8::f32x4*)d = acc[ai][0][m][0]; *(pg8::f32x4*)(d + 4) = acc[ai][0][m][1]; }
                }
            }
    }
};

struct EpiQ {
    static constexpr bool PERM = true;
    unsigned char* ws;
    __device__ __forceinline__ void operator()(const pg8::f32x4 (&acc)[2][2][4][2], const pg8::Unit& u, int wr, int wc, int fr, int fq) const {
        const float* SSQ = (const float*)(ws + WS_SSQQ); const float* ct = (const float*)(ws + WS_COS); const float* st = (const float*)(ws + WS_SIN); bf16* QM = (bf16*)(ws + WS_QM);
#pragma unroll
        for (int ai = 0; ai < 2; ++ai)
#pragma unroll
            for (int m = 0; m < 4; ++m) {
                const int r = u.pm * 256 + ai * 128 + wr * 64 + m * 16 + fr;
                const float sc = QS_MLA / sqrtf(SSQ[r] * (1.f / 512.f) + EPSN);
                const int pos = (r & (SEQ - 1)) + NMETA;
                bf16* orow = QM + (size_t)arow_of(r) * 768;
#pragma unroll
                for (int bj = 0; bj < 2; ++bj) {
                    const int c = u.pn * 256 + bj * 128 + wc * 32 + 8 * fq, d = c % 96;
                    pg8::f32x4 v0 = acc[ai][bj][m][0] * sc, v1 = acc[ai][bj][m][1] * sc;
                    if (d >= 64) {
                        const int i0 = (d - 64) >> 1;
                        const pg8::f32x4 cs = *(const pg8::f32x4*)(ct + pos * 16 + i0), sn = *(const pg8::f32x4*)(st + pos * 16 + i0);
                        pg8::f32x4 o0, o1;
                        o0[0] = v0[0] * cs[0] - v0[1] * sn[0]; o0[1] = v0[0] * sn[0] + v0[1] * cs[0];
                        o0[2] = v0[2] * cs[1] - v0[3] * sn[1]; o0[3] = v0[2] * sn[1] + v0[3] * cs[1];
                        o1[0] = v1[0] * cs[2] - v1[1] * sn[2]; o1[1] = v1[0] * sn[2] + v1[1] * cs[2];
                        o1[2] = v1[2] * cs[3] - v1[3] * sn[3]; o1[3] = v1[2] * sn[3] + v1[3] * cs[3];
                        v0 = o0; v1 = o1;
                    }
                    *(pg8::u32x4*)(orow + c) = pg8::pack8(v0, v1);
                }
            }
    }
};
struct EpiKV {
    static constexpr bool PERM = true;
    unsigned char* ws;
    __device__ __forceinline__ void operator()(const pg8::f32x4 (&acc)[2][2][4][2], const pg8::Unit& u, int wr, int wc, int fr, int fq) const {
        const float* SSKV = (const float*)(ws + WS_SSQKV);
#pragma unroll
        for (int ai = 0; ai < 2; ++ai)
#pragma unroll
            for (int m = 0; m < 4; ++m) {
                const int r = u.pm * 256 + ai * 128 + wr * 64 + m * 16 + fr;
                if (r >= TR + NMETA) continue;
                const float sc = 1.f / sqrtf(SSKV[r] * (1.f / 256.f) + EPSN);
                const int a0 = r < TR ? arow_of(r) : r - TR;
                const int j = wc * 32 + 8 * fq;
#pragma unroll
                for (int bj = 0; bj < 2; ++bj) {
                    const int h = u.pn * 2 + bj;
                    const pg8::u32x4 w = pg8::pack8(acc[ai][bj][m][0] * sc, acc[ai][bj][m][1] * sc);
                    unsigned char* dst = j < 64 ? ws + WS_KM + ((size_t)a0 * 768 + h * 96 + j) * 2 : ws + WS_VM + ((size_t)a0 * 512 + h * 64 + (j - 64)) * 2;
                    const size_t bstep = j < 64 ? (size_t)LP * 768 * 2 : (size_t)LP * 512 * 2;
                    *(pg8::u32x4*)dst = w;
                    if (r >= TR) *(pg8::u32x4*)(dst + bstep) = w;
                }
            }
    }
};
__device__ __forceinline__ float log2sig(float z) {
    const float t = exp2f(-fabsf(z) * LOG2E);
    return fminf(z, 0.f) * LOG2E - log2f(1.f + t);
}
__device__ __forceinline__ void p2_small(const Frame& F, const Ptrs& P) {
    unsigned char* ws = P.ws;
    {
        const int gt = F.vcu * (NWAVES * 64) + F.tid, NGT = F.G * NWAVES * 64;
        const float* KR = (const float*)(ws + WS_KR); const float* ct = (const float*)(ws + WS_COS); const float* st = (const float*)(ws + WS_SIN); bf16* KM = (bf16*)(ws + WS_KM);
        for (int i = gt; i < (TR + NMETA) * 4; i += NGT) {
            const int m = i >> 2, q = i & 3, pos = m < TR ? (m & (SEQ - 1)) + NMETA : m - TR, a0 = m < TR ? arow_of(m) : m - TR;
            const f32x4 v0 = *(const f32x4*)(KR + (size_t)m * 32 + q * 8), v1 = *(const f32x4*)(KR + (size_t)m * 32 + q * 8 + 4);
            const f32x4 cs = *(const f32x4*)(ct + pos * 16 + q * 4), sn = *(const f32x4*)(st + pos * 16 + q * 4);
            v4u w;
            w.x = pk2(v0[0] * cs[0] - v0[1] * sn[0], v0[0] * sn[0] + v0[1] * cs[0]); w.y = pk2(v0[2] * cs[1] - v0[3] * sn[1], v0[2] * sn[1] + v0[3] * cs[1]);
            w.z = pk2(v1[0] * cs[2] - v1[1] * sn[2], v1[0] * sn[2] + v1[1] * cs[2]); w.w = pk2(v1[2] * cs[3] - v1[3] * sn[3], v1[2] * sn[3] + v1[3] * cs[3]);
#pragma unroll
            for (int h = 0; h < 8; ++h) { bf16* d = KM + (size_t)a0 * 768 + h * 96 + 64 + q * 8; *(v4u*)d = w; if (m >= TR) *(v4u*)(d + (size_t)LP * 768) = w; }
        }
    }
    if (F.vcu < NB * 8) {
        const int b = F.vcu >> 3, h = F.vcu & 7, tid = F.tid;
        const float* FL = (const float*)(ws + WS_FL); const float bfh = P.in[4][h]; float* CB = (float*)(ws + WS_CB) + (size_t)(b * 8 + h) * LP;
        LAS float* sh = (LAS float*)(F.lds + RING_OFF);
        constexpr int PER = 17;
        float v[PER]; float run = 0.f;
#pragma unroll
        for (int k = 0; k < PER; ++k) { const int p = tid * PER + k; float x = 0.f;
            if (p < LSEQ) { const int m = p < NMETA ? TR + p : b * SEQ + (p - NMETA); x = log2sig(FL[(size_t)m * 8 + h] + bfh); }
            run += x; v[k] = run; }
        float incl = run;
#pragma unroll
        for (int o = 1; o < 64; o <<= 1) { const float t = __shfl_up(incl, o); if (F.lane >= o) incl += t; }
        if (F.lane == 63) sh[F.wave] = incl;
        LDS_WAIT(); __syncthreads();
        float base = incl - run;
        for (int w = 0; w < F.wave; ++w) base += sh[w];
#pragma unroll
        for (int k = 0; k < PER; ++k) { const int p = tid * PER + k; if (p < LSEQ) CB[p < NMETA ? p : 48 + p] = base + v[k]; }
        if (tid < 48) CB[16 + tid] = BIG;
        __syncthreads();
    }
}

namespace att {
typedef short bf16x8 __attribute__((ext_vector_type(8)));
typedef short s16x4 __attribute__((ext_vector_type(4)));
typedef float f32x16 __attribute__((ext_vector_type(16)));
typedef unsigned u32x4 __attribute__((ext_vector_type(4)));
typedef float f32x2_t __attribute__((ext_vector_type(2)));
typedef __bf16 bf16x2_t __attribute__((ext_vector_type(2)));
typedef short v4i16_t __attribute__((ext_vector_type(4)));
__device__ __forceinline__ int crow(int r, int hi) { return (r & 3) + 8 * (r >> 2) + 4 * hi; }
__device__ __forceinline__ unsigned cvtpk_s(float lo, float hi) { f32x2_t v = {lo, hi}; bf16x2_t b = __builtin_convertvector(v, bf16x2_t); return __builtin_bit_cast(unsigned, b); }
__device__ __forceinline__ s16x4 vtr(LAS const char* p) { return __builtin_bit_cast(s16x4, __builtin_amdgcn_ds_read_tr16_b64_v4i16((LAS v4i16_t*)p)); }
#define ATT_MX3(a, b, c) __builtin_fmaxf(__builtin_fmaxf((a), (b)), (c))
__device__ __forceinline__ float rowmax(const f32x16& p0, const f32x16& p1) {
    float a = ATT_MX3(p0[0], p0[1], p1[0]), b = ATT_MX3(p0[2], p0[3], p1[1]); a = ATT_MX3(a, p1[2], p1[3]);
#pragma unroll
    for (int r = 4; r < 16; r += 4) { a = ATT_MX3(a, p0[r], p0[r + 1]); b = ATT_MX3(b, p0[r + 2], p0[r + 3]); a = ATT_MX3(a, p1[r], p1[r + 1]); b = ATT_MX3(b, p1[r + 2], p1[r + 3]); }
    float m = __builtin_fmaxf(a, b); auto rr = __builtin_amdgcn_permlane32_swap(__float_as_uint(m), __float_as_uint(m), false, false);
    return __builtin_fmaxf(__uint_as_float(rr[0]), __uint_as_float(rr[1])); }
__device__ __forceinline__ void cmask(f32x16& p0, f32x16& p1, int jb, int qrel, int hi) {
    const int kb = 64 * jb + 4 * hi;
#pragma unroll
    for (int r = 0; r < 16; ++r) { const int kv = kb + (r & 3) + 8 * (r >> 2); if (kv > qrel) p0[r] = -INFINITY; if (kv + 32 > qrel) p1[r] = -INFINITY; } }

template <int DK> struct Lay {
    static constexpr int KB = 64 * DK * 2;
    static constexpr int K0 = 0, V0 = 2 * KB, BI = V0 + 2 * 8192, WS = BI + 512, OST = WS + NWAVES * 256, BYTES = OST + NWAVES * 4096;
};
struct Tens { const bf16* Q; int qp; const bf16* K; int kp; const bf16* V; const float* bias; bf16* Y; int ycol; };

template <int DK, bool FOX, int THR>
__device__ __forceinline__ void attn_unit(int b, int h, int qb, const Tens T, LAS char* shm) {
    typedef Lay<DK> LY; constexpr int NDK = DK / 16;
    const int tid = threadIdx.x, lane = tid & 63, r32 = lane & 31, hi = lane >> 5; const int wid = __builtin_amdgcn_readfirstlane(tid >> 6);
    const long ab = (long)b * LP; const int q0 = 64 + qb * 256, NT = 4 * qb + 5;
    const bf16* Kh = T.K + ab * T.kp + h * DK; const bf16* Vh = T.V + ab * 512 + h * 64;
    const float* bias = FOX ? T.bias + (size_t)(b * 8 + h) * LP : T.bias;
    LAS float* wsf = (LAS float*)(shm + LY::WS) + wid * 64;
#define ATT_DMA(t, buf) do { \
        for (int c_ = wid; c_ < DK / 8; c_ += NWAVES) \
            __builtin_amdgcn_global_load_lds((const unsigned*)(Kh + (long)(64 * (t) + lane) * T.kp + c_ * 8), (LAS unsigned*)(shm + LY::K0 + (buf) * LY::KB + c_ * 1024), 16, 0, 0); \
        __builtin_amdgcn_global_load_lds((const unsigned*)(Vh + (long)(64 * (t) + 16 * (wid & 3) + (lane >> 2)) * 512 + (wid >> 2) * 32 + (lane & 3) * 8), (LAS unsigned*)(shm + LY::V0 + (buf) * 8192 + wid * 1024), 16, 0, 0); \
    } while (0)
    const bool bias_lane = (wid == 0 && lane < 16);
    f32x4 bstage = (f32x4){0.f, 0.f, 0.f, 0.f};
    ATT_DMA(0, 0);
    if (bias_lane) bstage = *(const f32x4*)(bias + lane * 4);
    bf16x8 qr[NDK];
    { const bf16* Qw = T.Q + (ab + q0 + wid * 32 + r32) * T.qp + h * DK + hi * 8;
#pragma unroll
      for (int d0 = 0; d0 < NDK; ++d0) qr[d0] = *(const bf16x8*)(Qw + d0 * 16); }
    if (bias_lane) *(LAS f32x4*)(shm + LY::BI + lane * 16) = bstage;
    float mhat = 0.f, l_reg = 0.f; f32x16 o[2]; o[0] = f32x16{}; o[1] = f32x16{};
    const int qrel = wid * 32 + r32;
    asm volatile("s_waitcnt vmcnt(0) lgkmcnt(0)\n\ts_barrier" ::: "memory");
    for (int t = 0; t < NT; ++t) {
        const int buf = t & 1;
        const bool more = t + 1 < NT, nbias = more && (FOX) ;
        if (more) ATT_DMA(t + 1, buf ^ 1);
        if (nbias && bias_lane) bstage = *(const f32x4*)(bias + 64 * (t + 1) + lane * 4);
        const int jb = t - (NT - 4);
        if (!(jb >= 0 && 64 * jb > 32 * wid + 31)) {
            f32x16 c0, c1; const float nm = -mhat;
            if (FOX || t == 0) {
                LAS const char* bp = shm + LY::BI + buf * 256 + hi * 16;
#pragma unroll
                for (int g = 0; g < 4; ++g) { const f32x4 b0 = *(LAS const f32x4*)(bp + g * 32), b1 = *(LAS const f32x4*)(bp + 128 + g * 32);
#pragma unroll
                    for (int e = 0; e < 4; ++e) { c0[4 * g + e] = nm - b0[e]; c1[4 * g + e] = nm - b1[e]; } }
            } else {
#pragma unroll
                for (int r = 0; r < 16; ++r) { c0[r] = nm; c1[r] = nm; }
            }
            LAS const char* kp0 = shm + LY::K0 + buf * LY::KB + hi * 1024 + r32 * 16;
#pragma unroll
            for (int d0 = 0; d0 < NDK; ++d0) {
                const bf16x8 k0 = *(LAS const bf16x8*)(kp0 + d0 * 2048), k1 = *(LAS const bf16x8*)(kp0 + d0 * 2048 + 512);
                c0 = __builtin_amdgcn_mfma_f32_32x32x16_bf16(k0, qr[d0], c0, 0, 0, 0);
                c1 = __builtin_amdgcn_mfma_f32_32x32x16_bf16(k1, qr[d0], c1, 0, 0, 0);
            }
            if (jb >= 0) cmask(c0, c1, jb, qrel, hi);
            const float rm = rowmax(c0, c1);
            if (t == 0) {
                mhat += rm;
#pragma unroll
                for (int r = 0; r < 16; ++r) { c0[r] -= rm; c1[r] -= rm; }
            } else if (__any(rm > (float)THR)) {
                const float dl = __builtin_fmaxf(rm, 0.f); mhat += dl;
#pragma unroll
                for (int r = 0; r < 16; ++r) { c0[r] -= dl; c1[r] -= dl; }
                const float f = __builtin_amdgcn_exp2f(-dl); l_reg *= f;
                if (hi == 0) wsf[r32] = f;
                asm volatile("s_waitcnt lgkmcnt(0)" ::: "memory");
#pragma unroll
                for (int g = 0; g < 4; ++g) { const f32x4 fv = *(LAS const f32x4*)((LAS const char*)wsf + (8 * g + 4 * hi) * 4);
#pragma unroll
                    for (int e = 0; e < 4; ++e) { o[0][4 * g + e] *= fv[e]; o[1][4 * g + e] *= fv[e]; } }
            }
            float sacc = 0.f;
#pragma unroll
            for (int r = 0; r < 16; ++r) { c0[r] = __builtin_amdgcn_exp2f(c0[r]); c1[r] = __builtin_amdgcn_exp2f(c1[r]); sacc += c0[r] + c1[r]; }
            l_reg += sacc;
            u32x4 pw[4];
#pragma unroll
            for (int k = 0; k < 2; ++k)
#pragma unroll
                for (int e = 0; e < 4; ++e) { pw[k][e] = cvtpk_s(c0[8 * k + 2 * e], c0[8 * k + 2 * e + 1]); pw[2 + k][e] = cvtpk_s(c1[8 * k + 2 * e], c1[8 * k + 2 * e + 1]); }
            LAS const char* vp0 = shm + LY::V0 + buf * 8192 + ((lane >> 4) & 1) * 32 + (lane & 3) * 8 + (4 * hi + ((lane & 15) >> 2)) * 64;
#pragma unroll
            for (int d0 = 0; d0 < 2; ++d0)
#pragma unroll
                for (int ks = 0; ks < 4; ++ks) {
                    const s16x4 lo = vtr(vp0 + d0 * 4096 + ks * 1024), hh = vtr(vp0 + d0 * 4096 + ks * 1024 + 512);
                    const bf16x8 vf = (bf16x8){lo[0], lo[1], lo[2], lo[3], hh[0], hh[1], hh[2], hh[3]};
                    o[d0] = __builtin_amdgcn_mfma_f32_32x32x16_bf16(__builtin_bit_cast(bf16x8, pw[ks]), vf, o[d0], 0, 0, 0);
                }
        }
        if (nbias && bias_lane) *(LAS f32x4*)(shm + LY::BI + (buf ^ 1) * 256 + lane * 16) = bstage;
        asm volatile("s_waitcnt vmcnt(0) lgkmcnt(0)\n\ts_barrier" ::: "memory");
    }
    { auto rr = __builtin_amdgcn_permlane32_swap(__float_as_uint(l_reg), __float_as_uint(l_reg), false, false); l_reg = __uint_as_float(rr[0]) + __uint_as_float(rr[1]); }
    if (hi == 0) wsf[32 + r32] = l_reg;
    asm volatile("s_waitcnt lgkmcnt(0)" ::: "memory");
    float rli[16];
#pragma unroll
    for (int g = 0; g < 4; ++g) { const f32x4 lv = *(LAS const f32x4*)((LAS const char*)wsf + (32 + 8 * g + 4 * hi) * 4);
#pragma unroll
        for (int e = 0; e < 4; ++e) rli[4 * g + e] = __builtin_amdgcn_rcpf(lv[e]); }
    LAS unsigned short* stg = (LAS unsigned short*)(shm + LY::OST) + wid * 2048;
#pragma unroll
    for (int r = 0; r < 16; ++r) { const int orow = crow(r, hi);
#pragma unroll
        for (int d0 = 0; d0 < 2; ++d0) stg[orow * 64 + d0 * 32 + r32] = (unsigned short)f2bf(o[d0][r] * rli[r]); }
    asm volatile("s_waitcnt lgkmcnt(0)" ::: "memory");
    bf16* Ow = T.Y + ((size_t)b * SEQ + qb * 256 + wid * 32) * 1024 + T.ycol + h * 64;
#pragma unroll
    for (int i = 0; i < 4; ++i) { const int row = i * 8 + (lane >> 3), ch = lane & 7; const u32x4 v = *(LAS const u32x4*)(stg + row * 64 + ch * 8); *(u32x4*)(Ow + (size_t)row * 1024 + ch * 8) = v; }
    asm volatile("s_waitcnt lgkmcnt(0)\n\ts_barrier" ::: "memory");
#undef ATT_DMA
}
}

struct EpiGate {
    static constexpr bool PERM = true;
    const bf16* SG; bf16* MG; int accumulate;
    __device__ __forceinline__ void operator()(const pg8::f32x4 (&acc)[2][2][4][2], const pg8::Unit& u, int wr, int wc, int fr, int fq) const {
#pragma unroll
        for (int ai = 0; ai < 2; ++ai)
#pragma unroll
            for (int m = 0; m < 4; ++m) {
                const int r = u.pm * 256 + ai * 128 + wr * 64 + m * 16 + fr;
#pragma unroll
                for (int bj = 0; bj < 2; ++bj) {
                    const size_t off = (size_t)r * 1024 + u.pn * 256 + bj * 128 + wc * 32 + 8 * fq;
                    const pg8::u32x4 sg = *(const pg8::u32x4*)(SG + off);
                    pg8::f32x4 v0 = acc[ai][bj][m][0], v1 = acc[ai][bj][m][1];
#pragma unroll
                    for (int e = 0; e < 2; ++e) { v0[2 * e] *= __builtin_bit_cast(float, sg[e] << 16); v0[2 * e + 1] *= __builtin_bit_cast(float, sg[e] & 0xffff0000u);
                                                  v1[2 * e] *= __builtin_bit_cast(float, sg[2 + e] << 16); v1[2 * e + 1] *= __builtin_bit_cast(float, sg[2 + e] & 0xffff0000u); }
                    if (accumulate) { const pg8::u32x4 pv = *(const pg8::u32x4*)(MG + off);
#pragma unroll
                        for (int e = 0; e < 2; ++e) { v0[2 * e] += __builtin_bit_cast(float, pv[e] << 16); v0[2 * e + 1] += __builtin_bit_cast(float, pv[e] & 0xffff0000u);
                                                      v1[2 * e] += __builtin_bit_cast(float, pv[2 + e] << 16); v1[2 * e + 1] += __builtin_bit_cast(float, pv[2 + e] & 0xffff0000u); } }
                    *(pg8::u32x4*)(MG + off) = pg8::pack8(v0, v1);
                }
            }
    }
};
struct EpiRes {
    static constexpr bool PERM = false;
    const float* X; float* H1;
    __device__ __forceinline__ void operator()(const pg8::f32x4 (&acc)[2][2][4][2], const pg8::Unit& u, int wr, int wc, int fr, int fq) const {
#pragma unroll
        for (int ai = 0; ai < 2; ++ai)
#pragma unroll
            for (int m = 0; m < 4; ++m) {
                const size_t ro = (size_t)(u.pm * 256 + ai * 128 + wr * 64 + m * 16 + fr) * 1024 + u.pn * 256 + wc * 32 + 4 * fq;
#pragma unroll
                for (int bj = 0; bj < 2; ++bj)
#pragma unroll
                    for (int n = 0; n < 2; ++n) { const size_t off = ro + bj * 128 + n * 16; *(pg8::f32x4*)(H1 + off) = *(const pg8::f32x4*)(X + off) + acc[ai][bj][m][n]; }
            }
    }
};

constexpr size_t RT_RIDX = WS_RT, RT_RW = WS_RT + 128 * 1024, RT_RANK = WS_RT + 256 * 1024, RT_CNT = WS_RT + 384 * 1024, RT_TOKSLOT = WS_RT + 512 * 1024,
                 RT_ROWIDX = WS_RT + 640 * 1024, RT_ROWW = WS_RT + 832 * 1024, RT_TILEE = WS_RT + 1024 * 1024, RT_NT = WS_RT + 1024 * 1024 + 4096;
constexpr int MAXSLOT = 40960;
constexpr int RTAB_BYTES = 147456, P6_SCR = RTAB_BYTES;
__device__ __forceinline__ float wred(float v) { return wave_sum(v); }
__device__ __forceinline__ void p6a_route(const Frame& F, const Ptrs& P) {
    unsigned char* ws = P.ws; const int lane = F.lane, tid = F.tid;
    LAS f32x4* RTg = (LAS f32x4*)(F.lds);
    LAS f32x4* RTe = (LAS f32x4*)(F.lds + 16384);
    LAS int* eid = (LAS int*)(F.lds + P6_SCR);
    const float* wgr = P.in[13]; const float* wer = P.in[15];
    for (int i = tid; i < 1024; i += NWAVES * 64) { const int l = i & 63, je = i >> 6, k = 4 * (l + 64 * (je >> 2)) + (je & 3); RTg[i] = *(const f32x4*)(wgr + (size_t)k * 4); }
    for (int i = tid; i < 8192; i += NWAVES * 64) { const int l = i & 63, half = (i >> 6) & 1, g = (i >> 7) & 3, je = i >> 9, k = 4 * (l + 64 * (je >> 2)) + (je & 3);
        RTe[i] = *(const f32x4*)(wer + (size_t)k * 32 + 8 * g + 4 * half); }
    f32x4 gn[4];
#pragma unroll
    for (int j = 0; j < 4; ++j) gn[j] = ((const f32x4*)P.in[12])[lane + 64 * j];
    float bg[4], be_[32];
#pragma unroll
    for (int c = 0; c < 4; ++c) bg[c] = P.in[14][c];
    LDS_WAIT(); __syncthreads();
    const float* H1 = P.out; bf16* T = (bf16*)(ws + WS_T);
    int* RIDX = (int*)(ws + RT_RIDX); float* RW = (float*)(ws + RT_RW); int* RANK = (int*)(ws + RT_RANK); int* CNT = (int*)(ws + RT_CNT);
    (void)be_;
    for (int v = F.vcu; v < 256; v += F.G) {
        for (int i = 0; i < 8; ++i) {
            const int tl = F.wave * 8 + i, tok = v * 64 + tl;
            const f32x4* hr = (const f32x4*)(H1 + (size_t)tok * DM) + lane;
            f32x4 hv[4]; float ss = 0.f;
#pragma unroll
            for (int j = 0; j < 4; ++j) { hv[j] = hr[64 * j]; ss += (hv[j].x * hv[j].x + hv[j].y * hv[j].y) + (hv[j].z * hv[j].z + hv[j].w * hv[j].w); }
            const float rstd = 1.f / sqrtf(wave_sum(ss) * (1.f / DM) + EPSN);
            unsigned long long* o8 = (unsigned long long*)(T + (size_t)tok * DM) + lane;
            f32x4 a4 = (f32x4){0.f, 0.f, 0.f, 0.f};
#pragma unroll
            for (int j = 0; j < 4; ++j) { hv[j] = hv[j] * rstd * gn[j]; o8[64 * j] = (unsigned long long)pk2(hv[j].x, hv[j].y) | ((unsigned long long)pk2(hv[j].z, hv[j].w) << 32);
#pragma unroll
                for (int e = 0; e < 4; ++e) a4 += RTg[(j * 4 + e) * 64 + lane] * hv[j][e]; }
            float gl[4];
#pragma unroll
            for (int c = 0; c < 4; ++c) gl[c] = wave_sum(a4[c]) + bg[c];
            int g = 0; float gm = gl[0];
#pragma unroll
            for (int c = 1; c < 4; ++c) if (gl[c] > gm) { gm = gl[c]; g = c; }
            float gs = 0.f;
#pragma unroll
            for (int c = 0; c < 4; ++c) gs += expf(gl[c] - gm);
            const float gw = 1.f / gs;
            f32x4 e0 = (f32x4){0.f, 0.f, 0.f, 0.f}, e1 = e0;
#pragma unroll
            for (int j = 0; j < 4; ++j)
#pragma unroll
                for (int e = 0; e < 4; ++e) { const int base = (((j * 4 + e) * 4 + g) * 2) * 64 + lane; e0 += RTe[base] * hv[j][e]; e1 += RTe[base + 64] * hv[j][e]; }
            float el[8];
#pragma unroll
            for (int c = 0; c < 4; ++c) { el[c] = wave_sum(e0[c]) + P.in[16][g * 8 + c]; el[4 + c] = wave_sum(e1[c]) + P.in[16][g * 8 + 4 + c]; }
            int i0 = 0; float v0 = el[0];
#pragma unroll
            for (int c = 1; c < 8; ++c) if (el[c] > v0) { v0 = el[c]; i0 = c; }
            int i1 = -1; float v1 = -INFINITY;
#pragma unroll
            for (int c = 0; c < 8; ++c) if (c != i0 && el[c] > v1) { v1 = el[c]; i1 = c; }
            const float p1 = expf(v1 - v0), w0 = gw / (1.f + p1), w1 = gw * p1 / (1.f + p1);
            if (lane == 0) { RIDX[tok * 2] = g * 8 + i0; RIDX[tok * 2 + 1] = g * 8 + i1; RW[tok * 2] = w0; RW[tok * 2 + 1] = w1; eid[tl * 2] = g * 8 + i0; eid[tl * 2 + 1] = g * 8 + i1; }
        }
        LDS_WAIT(); __syncthreads();
        if (tid < 32) { int c = 0; for (int j = 0; j < 128; ++j) c += (eid[j] == tid) ? 1 : 0; CNT[v * 32 + tid] = c; }
        if (tid >= 64 && tid < 192) { const int a = tid - 64, me = eid[a]; int r = 0; for (int j = 0; j < a; ++j) r += (eid[j] == me) ? 1 : 0; RANK[(v * 64) * 2 + a] = r; }
        __syncthreads();
    }
}
__device__ __forceinline__ void p6b_lists(const Frame& F, const Ptrs& P) {
    unsigned char* ws = P.ws; const int tid = F.tid;
    LAS int* sh = (LAS int*)(F.lds + P6_SCR);
    const int* RIDX = (const int*)(ws + RT_RIDX); const float* RW = (const float*)(ws + RT_RW); const int* RANK = (const int*)(ws + RT_RANK); const int* CNT = (const int*)(ws + RT_CNT);
    int* TOKSLOT = (int*)(ws + RT_TOKSLOT); int* ROWIDX = (int*)(ws + RT_ROWIDX); float* ROWW = (float*)(ws + RT_ROWW); int* TILEE = (int*)(ws + RT_TILEE); int* NT = (int*)(ws + RT_NT);
    for (int v = F.vcu; v < 256; v += F.G) {
        if (tid < 32) { int tot = 0, pre = 0; for (int j = 0; j < 256; ++j) { const int c = CNT[j * 32 + tid]; tot += c; pre += j < v ? c : 0; } sh[tid] = tot; sh[32 + tid] = pre; }
        LDS_WAIT(); __syncthreads();
        if (tid == 0) { int b = 0; for (int e = 0; e < 32; ++e) { sh[64 + e] = b; b += (sh[e] + 255) & ~255; } sh[96] = b; }
        LDS_WAIT(); __syncthreads();
        if (tid < 128) { const int a = tid, tok = v * 64 + (a >> 1), e = RIDX[(v * 64) * 2 + a]; const int slot = sh[64 + e] + sh[32 + e] + RANK[(v * 64) * 2 + a];
            ROWIDX[slot] = tok; ROWW[slot] = RW[(v * 64) * 2 + a]; TOKSLOT[(v * 64) * 2 + a] = slot; }
        if (v < 32) {
            const int e = v, b0 = sh[64 + e], tot = sh[e], pad = (tot + 255) & ~255;
            for (int s = tot + tid; s < pad; s += NWAVES * 64) { ROWIDX[b0 + s] = 0; ROWW[b0 + s] = 0.f; }
            for (int t = tid; t < pad / 256; t += NWAVES * 64) TILEE[b0 / 256 + t] = e;
            if (e == 0 && tid == 0) NT[0] = sh[96] / 256;
        }
        __syncthreads();
    }
}
struct MoeOrder {
    const int* tilee; int ntiles, nc, G, c;
    __device__ __forceinline__ bool next(int i, pg8::Unit& u) const {
        const int L = i * G + c; if (L >= ntiles * nc) return false;
        u.pm = L / nc; u.pn = L % nc; u.be = tilee[u.pm]; return true; }
};
struct EpiUp {
    static constexpr bool PERM = true;
    const float* ROWW; bf16* HM;
    __device__ __forceinline__ void operator()(const pg8::f32x4 (&acc)[2][2][4][2], const pg8::Unit& u, int wr, int wc, int fr, int fq) const {
#pragma unroll
        for (int ai = 0; ai < 2; ++ai)
#pragma unroll
            for (int m = 0; m < 4; ++m) {
                const int r = u.pm * 256 + ai * 128 + wr * 64 + m * 16 + fr; const float cw = ROWW[r];
                pg8::f32x4 o[2];
#pragma unroll
                for (int n = 0; n < 2; ++n)
#pragma unroll
                    for (int e = 0; e < 4; ++e) { const float a = acc[ai][0][m][n][e], b = acc[ai][1][m][n][e]; o[n][e] = a * sigmoid_fast(a) * b * cw; }
                *(pg8::u32x4*)(HM + (size_t)r * FE + u.pn * 128 + wc * 32 + 8 * fq) = pg8::pack8(o[0], o[1]);
            }
    }
};
struct EpiDown {
    static constexpr bool PERM = true;
    bf16* YE;
    __device__ __forceinline__ void operator()(const pg8::f32x4 (&acc)[2][2][4][2], const pg8::Unit& u, int wr, int wc, int fr, int fq) const {
#pragma unroll
        for (int ai = 0; ai < 2; ++ai)
#pragma unroll
            for (int m = 0; m < 4; ++m) {
                const size_t ro = (size_t)(u.pm * 256 + ai * 128 + wr * 64 + m * 16 + fr) * 1024 + u.pn * 256 + wc * 32 + 8 * fq;
#pragma unroll
                for (int bj = 0; bj < 2; ++bj) *(pg8::u32x4*)(YE + ro + bj * 128) = pg8::pack8(acc[ai][bj][m][0], acc[ai][bj][m][1]);
            }
    }
};
__device__ __forceinline__ void p9_final(const Frame& F, const Ptrs& P) {
    unsigned char* ws = P.ws; const int lane = F.lane; const int gw = F.vcu * NWAVES + F.wave, NGW = F.G * NWAVES;
    const int* TOKSLOT = (const int*)(ws + RT_TOKSLOT); const bf16* YE = (const bf16*)(ws + WS_YE);
    f32x4 gn[4];
#pragma unroll
    for (int j = 0; j < 4; ++j) gn[j] = ((const f32x4*)P.in[20])[lane + 64 * j];
    for (int tok = gw; tok < TR; tok += NGW) {
        const int s0 = TOKSLOT[tok * 2], s1 = TOKSLOT[tok * 2 + 1];
        f32x4* hr = (f32x4*)(P.out + (size_t)tok * DM) + lane;
        const unsigned long long* y0 = (const unsigned long long*)(YE + (size_t)s0 * DM) + lane; const unsigned long long* y1 = (const unsigned long long*)(YE + (size_t)s1 * DM) + lane;
        f32x4 v[4]; float ss = 0.f;
#pragma unroll
        for (int j = 0; j < 4; ++j) { v[j] = hr[64 * j]; const unsigned long long a = y0[64 * j], b = y1[64 * j];
            v[j].x += bf2f((unsigned short)a) + bf2f((unsigned short)b); v[j].y += bf2f((unsigned short)(a >> 16)) + bf2f((unsigned short)(b >> 16));
            v[j].z += bf2f((unsigned short)(a >> 32)) + bf2f((unsigned short)(b >> 32)); v[j].w += bf2f((unsigned short)(a >> 48)) + bf2f((unsigned short)(b >> 48));
            ss += (v[j].x * v[j].x + v[j].y * v[j].y) + (v[j].z * v[j].z + v[j].w * v[j].w); }
        const float rstd = 1.f / sqrtf(wave_sum(ss) * (1.f / DM) + EPSN);
#pragma unroll
        for (int j = 0; j < 4; ++j) hr[64 * j] = v[j] * rstd * gn[j];
    }
}

__global__ void __launch_bounds__(NWAVES * 64, 2) mega(Ptrs P) {
    extern __shared__ __attribute__((aligned(16))) unsigned char lds_raw[];
    Frame F;
    F.lds = (LAS unsigned char*)lds_raw;
    F.MISC = (volatile LAS unsigned*)(F.lds + MISC_OFF);
    F.tid = threadIdx.x; F.lane = F.tid & 63; F.wave = __builtin_amdgcn_readfirstlane(F.tid >> 6);
    F.G = gridDim.x; { const int bx = blockIdx.x; F.vcu = (F.G % 8 == 0) ? (bx % 8) * (F.G / 8) + bx / 8 : bx; }
    unsigned char* ws = P.ws;
    F.ctl = (unsigned*)(ws + WS_CTL);
    for (int u = F.tid; u < (LDS_BYTES - LDSCTL_OFF) / 4; u += NWAVES * 64) ((LAS unsigned*)(F.lds + LDSCTL_OFF))[u] = 0u;
    __syncthreads();
    const int lo = P.ph_lo, hi = P.ph_hi;
    XcdBarrier bar; bar.bar = F.ctl + CW_BAR; bar.x = 0; bar.st = nullptr;
    if (hi - lo > 1) bar = xcd_barrier_post(F.ctl + CW_BAR, F.MISC + 8);
#define IN(k) (lo <= (k) && (k) < hi)
#define SEAM(k) do { if (IN(k) && IN((k) + 1)) xcd_barrier(bar); } while (0)

    if (IN(0)) { p0_prologue(F, P); } SEAM(0);
    if (IN(1)) {
        pg8::Gemm g{(const bf16*)(ws + WS_U), (const bf16*)(ws + WS_WIN), DM, DM, nullptr, 0};
        DenseOrder S; S.init(MROWS / 256, NIN / 256, F.G, (int)blockIdx.x);
        EpiP1 E{ws, (bf16*)P.out};
        pg8::gemm_phase<EpiP1, DenseOrder, true>(F.lds + RING_OFF, g, S, E);
    } SEAM(1);
    if (IN(2)) {
        { pg8::Gemm g{(const bf16*)(ws + WS_CQ), (const bf16*)(ws + WS_WQUP), 512, 512, nullptr, 0}; DenseOrder S; S.init(TR / 256, 3, F.G, (int)blockIdx.x);
          EpiQ E{ws}; pg8::gemm_phase<EpiQ, DenseOrder, true>(F.lds + RING_OFF, g, S, E); }
        { pg8::Gemm g{(const bf16*)(ws + WS_CKV), (const bf16*)(ws + WS_WKVUP), 256, 256, nullptr, 0}; DenseOrder S; S.init(MROWS / 256, 4, F.G, (int)blockIdx.x);
          EpiKV E{ws}; pg8::gemm_phase<EpiKV, DenseOrder, true>(F.lds + RING_OFF, g, S, E); }
        p2_small(F, P);
    } SEAM(2);
    if (IN(3)) {
        const att::Tens TM{(const bf16*)(ws + WS_QM), 768, (const bf16*)(ws + WS_KM), 768, (const bf16*)(ws + WS_VM), (const float*)(ws + WS_BIAS0), (bf16*)(ws + WS_Y), 0};
        const att::Tens TF{(const bf16*)(ws + WS_FQ), 512, (const bf16*)(ws + WS_FK), 512, (const bf16*)(ws + WS_FV), (const float*)(ws + WS_CB), (bf16*)(ws + WS_Y), 512};
        LAS char* shm = (LAS char*)(F.lds + RING_OFF);
        for (int v = F.vcu; v < 256; v += F.G) {
            const int bh = v >> 4, s = v & 15, b = bh >> 3, h = bh & 7;
            att::attn_unit<96, false, 8>(b, h, 31 - s, TM, shm);
            att::attn_unit<64, true, 8>(b, h, 31 - s, TF, shm);
            att::attn_unit<96, false, 8>(b, h, s, TM, shm);
            att::attn_unit<64, true, 8>(b, h, s, TF, shm);
        }
    } SEAM(3);
    if (IN(4)) {
        DenseOrder S; S.init(TR / 256, 4, F.G, (int)blockIdx.x);
        { pg8::Gemm g{(const bf16*)(ws + WS_Y), (const bf16*)(ws + WS_WA), 512, 1024, nullptr, 0};
          EpiGate E{(const bf16*)P.out, (bf16*)(ws + WS_MERGED), 0}; pg8::gemm_phase<EpiGate, DenseOrder, true>(F.lds + RING_OFF, g, S, E); }
        { pg8::Gemm g{(const bf16*)(ws + WS_Y) + 512, (const bf16*)(ws + WS_WB), 512, 1024, nullptr, 0};
          EpiGate E{(const bf16*)P.out + (size_t)TR * 1024, (bf16*)(ws + WS_MERGED), 1}; pg8::gemm_phase<EpiGate, DenseOrder, true>(F.lds + RING_OFF, g, S, E); }
    } SEAM(4);
    if (IN(5)) {
        DenseOrder S; S.init(TR / 256, 4, F.G, (int)blockIdx.x);
        pg8::Gemm g{(const bf16*)(ws + WS_MERGED), (const bf16*)(ws + WS_WOUT), 1024, 1024, nullptr, 0};
        EpiRes E{P.in[0], P.out}; pg8::gemm_phase<EpiRes, DenseOrder, true>(F.lds + RING_OFF, g, S, E);
    } SEAM(5);
    if (IN(6)) { p6a_route(F, P); } SEAM(6);
    if (IN(7)) { p6b_lists(F, P); } SEAM(7);
    if (IN(8)) {
        MoeOrder S{(const int*)(ws + RT_TILEE), *(const int*)(ws + RT_NT), 2, F.G, F.vcu};
        pg8::Gemm g{(const bf16*)(ws + WS_T), (const bf16*)(ws + WS_WUP), 1024, 1024, (const int*)(ws + RT_ROWIDX), (size_t)512 * 1024 * 2};
        EpiUp E{(const float*)(ws + RT_ROWW), (bf16*)(ws + WS_HM)}; pg8::gemm_phase<EpiUp, MoeOrder, true>(F.lds + RING_OFF, g, S, E);
    } SEAM(8);
    if (IN(9)) {
        MoeOrder S{(const int*)(ws + RT_TILEE), *(const int*)(ws + RT_NT), 4, F.G, F.vcu};
        pg8::Gemm g{(const bf16*)(ws + WS_HM), (const bf16*)(ws + WS_WD), 256, 256, nullptr, (size_t)1024 * 256 * 2};
        EpiDown E{(bf16*)(ws + WS_YE)}; pg8::gemm_phase<EpiDown, MoeOrder, true>(F.lds + RING_OFF, g, S, E);
    } SEAM(9);
    if (IN(10)) { p9_final(F, P); }
#undef IN
#undef SEAM
}


namespace chk {
constexpr int CW_ERR = 2048;
__device__ __forceinline__ unsigned hash(unsigned x) { x ^= x >> 16; x *= 0x7feb352dU; x ^= x >> 15; x *= 0x846ca68bU; x ^= x >> 16; return x; }
__device__ __forceinline__ void report(unsigned* ctl, int id, float err) { if (!(err >= 0.f)) err = 1e30f; atomicMax(ctl + CW_ERR + id, __float_as_uint(err)); }
__global__ void chk_p1(Ptrs P, int nsamp) {
    const int s = blockIdx.x * blockDim.x + threadIdx.x; if (s >= nsamp) return;
    unsigned char* ws = P.ws; unsigned* ctl = (unsigned*)(ws + WS_CTL);
    const unsigned h1 = hash(2 * s + 1), h2 = hash(2 * s + 2);
    int m = (s & 7) == 0 ? TR + (h1 % 16) : h1 % TR;
    const int n = h2 % DIN;
    const float* xr = m < TR ? P.in[0] + (size_t)m * DM : P.in[1] + (size_t)(m - TR) * DM;
    float ss = 0.f; for (int k = 0; k < DM; ++k) ss += xr[k] * xr[k];
    const float rstd = 1.f / sqrtf(ss / DM + EPSN);
    const int sc = srccol_in(n); float ref = 0.f;
    for (int k = 0; k < DM; ++k) ref += xr[k] * rstd * P.in[2][k] * P.in[3][(size_t)k * DIN + sc];
    float got; int id;
    if (n < 512) { got = bf2f(((const bf16*)(ws + WS_CQ))[(size_t)m * 512 + n]); id = 0; }
    else if (n < 768) { got = bf2f(((const bf16*)(ws + WS_CKV))[(size_t)m * 256 + n - 512]); id = 1; }
    else if (n < 2304) { const int seg = (n - 768) / 512, c = (n - 768) % 512; const bf16* base = (const bf16*)(ws + (seg == 0 ? WS_FQ : seg == 1 ? WS_FK : WS_FV));
        const int a0 = m < TR ? arow_of(m) : (m - TR) + ((h1 >> 8) & 1) * LP; got = bf2f(base[(size_t)a0 * 512 + c]); if (seg == 0) ref *= QS_FOX; id = 2 + seg; }
    else if (n < 4352) { if (m >= TR) return; const int which = (n - 2304) / 1024, c = (n - 2304) % 1024; got = bf2f(((const bf16*)P.out)[(size_t)which * TR * 1024 + (size_t)m * 1024 + c]); ref = 1.f / (1.f + expf(-ref)); id = 5 + which; }
    else if (n < 4384) { got = ((const float*)(ws + WS_KR))[(size_t)m * 32 + n - 4352]; id = 7; }
    else { got = ((const float*)(ws + WS_FL))[(size_t)m * 8 + n - 4384]; id = 8; }
    report(ctl, id, fabsf(got - ref));
    if ((s & 63) == 1) {
        float a = 0.f; for (int c = 0; c < 512; ++c) { const float v = bf2f(((const bf16*)(ws + WS_CQ))[(size_t)m * 512 + c]); a += v * v; }
        report(ctl, 9, fabsf(a - ((const float*)(ws + WS_SSQQ))[m]) / (a + 1e-3f));
        a = 0.f; for (int c = 0; c < 256; ++c) { const float v = bf2f(((const bf16*)(ws + WS_CKV))[(size_t)m * 256 + c]); a += v * v; }
        report(ctl, 10, fabsf(a - ((const float*)(ws + WS_SSQKV))[m]) / (a + 1e-3f));
    }
}
}

namespace chk {
struct Tol { float t[64]; };
__global__ void chk_report(Ptrs P, Tol tol, int nids, int force) {
    unsigned* ctl = (unsigned*)(P.ws + WS_CTL);
    int bad = -1; float e = 0.f;
    for (int i = 0; i < nids; ++i) { const float v = __uint_as_float(ctl[CW_ERR + i]); if (v > tol.t[i]) { bad = i; e = v; break; } }
    if (bad < 0 && !force) return;
    float code;
    if (bad < 0) code = 0.f;
    else { int b = e >= 1.f ? 0 : (int)floorf(-log2f(e)); if (b > 9) b = 9; if (b < 0) b = 0;
        const int a = bad % 9 + 1, grp = bad / 9; code = (float)(10 * a + b) * (grp == 0 ? 1.f : grp == 1 ? 100.f : 10000.f) - 1.f; }
    const float c = sqrtf(code);
    for (size_t i = (size_t)blockIdx.x * blockDim.x + threadIdx.x; i < (size_t)TR * DM; i += (size_t)gridDim.x * blockDim.x) P.out[i] = c;
}
}


extern "C" void kernel_launch(void* const* d_in, const int* in_sizes, int n_in, void* d_out, int out_size, void* d_ws, size_t ws_size, hipStream_t stream) {
    static int grid = 0;
    if (grid == 0) {
        if (n_in != 21 || out_size != TR * DM || ws_size < WS_END) { fprintf(stderr, "kernel_launch: unexpected shapes (n_in %d, out %d, ws %zu)\n", n_in, out_size, ws_size); grid = -1; return; }
        int dev = 0, cus = 0;
        if (hipGetDevice(&dev) != hipSuccess || hipDeviceGetAttribute(&cus, hipDeviceAttributeMultiprocessorCount, dev) != hipSuccess) { grid = -1; return; }
        if (hipFuncSetAttribute((const void*)mega, hipFuncAttributeMaxDynamicSharedMemorySize, LDS_BYTES) != hipSuccess) { fprintf(stderr, "kernel_launch: hipFuncSetAttribute failed\n"); grid = -1; return; }
        int per_cu = 0; (void)hipOccupancyMaxActiveBlocksPerMultiprocessor(&per_cu, (const void*)mega, NWAVES * 64, LDS_BYTES); (void)hipGetLastError();
        grid = cus;
    }
    if (grid < 0) return;
    (void)hipMemsetAsync((char*)d_ws + WS_CTL, 0, CTL_ZERO_BYTES, stream);
    Ptrs p{};
    for (int i = 0; i < 21; ++i) p.in[i] = (const float*)d_in[i];
    p.out = (float*)d_out; p.ws = (unsigned char*)d_ws;
    p.ph_lo = 0; p.ph_hi = 11;
    hipLaunchKernelGGL(mega, dim3(grid), dim3(NWAVES * 64), LDS_BYTES, stream, p);

}
```

```cpp
#include <hip/hip_runtime.h>
#include <cstdio>
#include <cstdint>
#include <cmath>

namespace pg8 {
#define PG8_LAS __attribute__((address_space(3)))
typedef unsigned short bf16_t;
typedef short bf16x8 __attribute__((ext_vector_type(8)));
typedef float f32x4 __attribute__((ext_vector_type(4)));
typedef unsigned u32x4 __attribute__((ext_vector_type(4)));
constexpr int BM = 256, BK = 64, HALF = 128, HTB = HALF * BK * 2  , STAGE_BYTES = 8 * HTB;

__host__ __device__ __forceinline__ int lds_byte(int r, int c) { const int st = (r >> 4) * 2 + (c >> 5), rr = r & 15, cc = c & 31, ob = rr * 64 + cc * 2; return st * 1024 + (ob ^ (((ob >> 9) & 1) << 5)); }
__host__ __device__ __forceinline__ void stage_rc(int b, int& R, int& C) { const int st = b / 1024, sb = b % 1024, swz = sb ^ (((sb >> 9) & 1) << 5); R = (st >> 1) * 16 + swz / 64; C = (st & 1) * 32 + (swz % 64) / 2; }
__host__ __device__ __forceinline__ int perm32(int rho) { const int n = rho >> 4, i = rho & 15; return 8 * (i >> 2) + 4 * n + (i & 3); }

struct Unit { int pm, pn, be; };
struct Gemm { const bf16_t* A; const bf16_t* Bt; int K, lda; const int* rowidx; size_t bstride; };

__device__ __forceinline__ unsigned cvt_pk_bf16(float lo, float hi) { unsigned r; asm volatile("v_cvt_pk_bf16_f32 %0, %1, %2" : "=v"(r) : "v"(lo), "v"(hi)); return r; }
__device__ __forceinline__ u32x4 pack8(const f32x4 v0, const f32x4 v1) { u32x4 w; w.x = cvt_pk_bf16(v0[0], v0[1]); w.y = cvt_pk_bf16(v0[2], v0[3]); w.z = cvt_pk_bf16(v1[0], v1[1]); w.w = cvt_pk_bf16(v1[2], v1[3]); return w; }

template <class Epi, class Sched, bool ALIGN_EPI>
__device__ __forceinline__ void gemm_phase(PG8_LAS unsigned char* lds, const Gemm g, const Sched& S, const Epi& E) {
    const int tid = threadIdx.x, wid = __builtin_amdgcn_readfirstlane(tid >> 6), lane = tid & 63, wr = wid >> 2, wc = wid & 3, fr = lane & 15, fq = lane >> 4;
    const int K = g.K, nt = K / BK;
    int sR[2], sC[2]; unsigned voffB[2];
#pragma unroll
    for (int i = 0; i < 2; ++i) { int R, C; stage_rc(tid * 16 + i * 8192, R, C); const int Rb = Epi::PERM ? ((R & ~31) + perm32(R & 31)) : R;
        sR[i] = R; sC[i] = C; voffB[i] = (unsigned)(Rb * K + C) * 2u; }
    const size_t kstep = (size_t)(BK * 2);
    const size_t hstepB = (size_t)HALF * K * 2;
    const size_t tstepB = 2 * hstepB;
    const unsigned ldsw = (unsigned)wid * 1024u;
    const int aoff = lds_byte(wr * 64 + fr, fq * 8), boff = lds_byte(wc * 32 + fr, fq * 8);
#define PG8_MKV(v, u) do { _Pragma("unroll") for (int _h = 0; _h < 2; ++_h) _Pragma("unroll") for (int _i = 0; _i < 2; ++_i) { \
        const int _tr = (u).pm * BM + _h * HALF + sR[_i]; const int _row = g.rowidx ? g.rowidx[_tr] : _tr; (v)[_h][_i] = ((unsigned)_row * (unsigned)g.lda + (unsigned)sC[_i]) * 2u; } } while (0)
#define PG8_SA(b, h) (((b) * 2 + (h)) * HTB)
#define PG8_SB(b, h) ((4 + (b) * 2 + (h)) * HTB)
#define PG8_STAGE(bufoff, gbase, voff) do { _Pragma("unroll") for (int _i = 0; _i < 2; ++_i) \
        __builtin_amdgcn_global_load_lds((const unsigned*)((const char*)(gbase) + (voff)[_i]), (PG8_LAS unsigned*)(lds + (bufoff) + ldsw + _i * 8192), 16, 0, 0); } while (0)
#define PG8_LDA(dst, b, h) do { _Pragma("unroll") for (int m = 0; m < 4; ++m) _Pragma("unroll") for (int k = 0; k < 2; ++k) dst[m][k] = *(const PG8_LAS bf16x8*)(lds + PG8_SA(b, h) + aoff + m * 2048 + k * 1024); } while (0)
#define PG8_LDB(dst, b, h) do { _Pragma("unroll") for (int n = 0; n < 2; ++n) _Pragma("unroll") for (int k = 0; k < 2; ++k) dst[n][k] = *(const PG8_LAS bf16x8*)(lds + PG8_SB(b, h) + boff + n * 2048 + k * 1024); } while (0)
#define PG8_MMA(ai, bj, At, Bt) do { __builtin_amdgcn_s_setprio(1); _Pragma("unroll") for (int m = 0; m < 4; ++m) _Pragma("unroll") for (int n = 0; n < 2; ++n) _Pragma("unroll") for (int k = 0; k < 2; ++k) \
        acc[ai][bj][m][n] = __builtin_amdgcn_mfma_f32_16x16x32_bf16(Bt[n][k], At[m][k], acc[ai][bj][m][n], 0, 0, 0); __builtin_amdgcn_s_setprio(0); } while (0)
#define PG8_WAIT_V(n) asm volatile("s_waitcnt vmcnt(" #n ")" ::: "memory")
#define PG8_WAIT_L(n) asm volatile("s_waitcnt lgkmcnt(" #n ")" ::: "memory")
#define PG8_BAR __builtin_amdgcn_s_barrier()
#define PG8_SCHED __builtin_amdgcn_sched_barrier(0)
    Unit cur, nxt; int ui = 0;
    if (!S.next(0, cur)) return;
    f32x4 acc[2][2][4][2];
#pragma unroll
    for (int a = 0; a < 2; ++a)
#pragma unroll
        for (int b = 0; b < 2; ++b)
#pragma unroll
            for (int m = 0; m < 4; ++m)
#pragma unroll
                for (int n = 0; n < 2; ++n) acc[a][b][m][n] = (f32x4){0.f, 0.f, 0.f, 0.f};
    bf16x8 At[4][2], B0[2][2], B1[2][2];
    unsigned vA[2][2], vN[2][2];
    PG8_MKV(vA, cur);
    const char* const pA = (const char*)g.A;
    const char* cB = (const char*)g.Bt + (size_t)cur.be * g.bstride + (size_t)cur.pn * tstepB;
    PG8_STAGE(PG8_SB(0, 0), cB, voffB); PG8_STAGE(PG8_SB(0, 1), cB + hstepB, voffB); PG8_STAGE(PG8_SA(0, 0), pA, vA[0]); PG8_STAGE(PG8_SA(0, 1), pA, vA[1]);
    if (wr == 1) PG8_BAR;
    PG8_WAIT_V(2); PG8_BAR;
    PG8_STAGE(PG8_SB(1, 0), cB + kstep, voffB); PG8_STAGE(PG8_SA(1, 0), pA + kstep, vA[0]); PG8_STAGE(PG8_SB(1, 1), cB + hstepB + kstep, voffB);
    PG8_WAIT_V(6); PG8_BAR;
    for (;;) {
        const bool has_next = S.next(ui + 1, nxt);
        if (has_next) PG8_MKV(vN, nxt);
        else {
#pragma unroll
            for (int h = 0; h < 2; ++h)
#pragma unroll
                for (int i = 0; i < 2; ++i) vN[h][i] = vA[h][i];
        }
        const char* nB = has_next ? (const char*)g.Bt + (size_t)nxt.be * g.bstride + (size_t)nxt.pn * tstepB : cB;
        for (int t = 0; t < nt; t += 2) {
            const bool last = (t == nt - 2);
            const char* a1 = pA + (size_t)(t + 1) * kstep;
            const char* a2 = last ? pA : pA + (size_t)(t + 2) * kstep; const char* b2 = last ? nB : cB + (size_t)(t + 2) * kstep;
            const char* a3 = a2 + kstep; const char* b3 = b2 + kstep;
            unsigned w0[2], w1[2];
#pragma unroll
            for (int i = 0; i < 2; ++i) { w0[i] = last ? vN[0][i] : vA[0][i]; w1[i] = last ? vN[1][i] : vA[1][i]; }
            PG8_LDB(B0, 0, 0); PG8_LDB(B1, 0, 1); PG8_SCHED; PG8_LDA(At, 0, 0); PG8_STAGE(PG8_SA(1, 1), a1, vA[1]);
            PG8_WAIT_V(8); PG8_WAIT_L(0); PG8_BAR; PG8_MMA(0, 0, At, B0); PG8_MMA(0, 1, At, B1); PG8_BAR; PG8_SCHED;
            PG8_LDA(At, 0, 1); PG8_STAGE(PG8_SB(0, 0), b2, voffB); PG8_STAGE(PG8_SB(0, 1), b2 + hstepB, voffB); PG8_STAGE(PG8_SA(0, 0), a2, w0);
            PG8_WAIT_V(8); PG8_WAIT_L(0); PG8_BAR; PG8_MMA(1, 0, At, B0); PG8_MMA(1, 1, At, B1); PG8_BAR; PG8_SCHED;
            PG8_LDB(B0, 1, 0); PG8_LDB(B1, 1, 1); PG8_SCHED; PG8_LDA(At, 1, 0); PG8_STAGE(PG8_SA(0, 1), a2, w1);
            PG8_WAIT_V(8); PG8_WAIT_L(0); PG8_BAR; PG8_MMA(0, 0, At, B0); PG8_MMA(0, 1, At, B1); PG8_BAR; PG8_SCHED;
            PG8_LDA(At, 1, 1); PG8_STAGE(PG8_SB(1, 0), b3, voffB); PG8_STAGE(PG8_SB(1, 1), b3 + hstepB, voffB); PG8_STAGE(PG8_SA(1, 0), a3, w0);
            PG8_WAIT_V(8); PG8_WAIT_L(0); PG8_BAR; PG8_MMA(1, 0, At, B0); PG8_MMA(1, 1, At, B1); PG8_BAR; PG8_SCHED;
        }
        if constexpr (ALIGN_EPI) { if (wr == 0) PG8_BAR; }
        E(acc, cur, wr, wc, fr, fq);
        if (!has_next) break;
#pragma unroll
        for (int a = 0; a < 2; ++a)
#pragma unroll
            for (int b = 0; b < 2; ++b)
#pragma unroll
                for (int m = 0; m < 4; ++m)
#pragma unroll
                    for (int n = 0; n < 2; ++n) acc[a][b][m][n] = (f32x4){0.f, 0.f, 0.f, 0.f};
        cur = nxt; cB = nB; ++ui;
#pragma unroll
        for (int h = 0; h < 2; ++h)
#pragma unroll
            for (int i = 0; i < 2; ++i) vA[h][i] = vN[h][i];
        if constexpr (ALIGN_EPI) { if (wr == 1) PG8_BAR; }
    }
    PG8_WAIT_V(0);
    if constexpr (!ALIGN_EPI) { if (wr == 0) PG8_BAR; }
    PG8_BAR;
#undef PG8_MKV
#undef PG8_SA
#undef PG8_SB
#undef PG8_STAGE
#undef PG8_LDA
#undef PG8_LDB
#undef PG8_MMA
#undef PG8_WAIT_V
#undef PG8_WAIT_L
#undef PG8_BAR
#undef PG8_SCHED
}
}

#define GAS __attribute__((address_space(1)))
#define LAS __attribute__((address_space(3)))
#define XB_TMO      128
#define XB_XCNT(j)  (256  + 64 * (j))
#define XB_XSUB(j)  (1280 + 64 * (j))
#define XB_XGEN(j)  (2304 + 64 * (j))
#define XB_TOP      3328
#define XB_TOPGEN   3392
#define XCD_BAR_WORDS 3456
#define XB_SPIN_CAP (1u << 18)

__device__ __forceinline__ unsigned xb_ld(unsigned* p)              { return __hip_atomic_load(p, __ATOMIC_RELAXED, __HIP_MEMORY_SCOPE_AGENT); }
__device__ __forceinline__ unsigned xb_add(unsigned* p, unsigned v) { return __hip_atomic_fetch_add(p, v, __ATOMIC_RELAXED, __HIP_MEMORY_SCOPE_AGENT); }
__device__ __forceinline__ unsigned xb_xcc_id() { return (unsigned)__builtin_amdgcn_s_getreg((3 << 11) | 20) & 0xFu; }
#define XB_SPIN(cond, bar) do { unsigned _sp = 0; while (cond) { __builtin_amdgcn_s_sleep(1); \
    if ((++_sp & 255u) == 0u) { if (xb_ld(&(bar)[XB_TMO])) break; if (_sp > XB_SPIN_CAP) { atomicAdd(&(bar)[XB_TMO], 1u); break; } } } } while (0)

struct XcdBarrier { unsigned* bar; unsigned x; volatile LAS unsigned* st; };

__device__ __forceinline__ XcdBarrier xcd_barrier_post(unsigned* bar, volatile LAS unsigned* st) {
    XcdBarrier b; b.bar = bar; b.x = xb_xcc_id(); b.st = st;
    if (threadIdx.x == 0) (void)xb_add(&bar[XB_XCNT(b.x)], 1u);
    return b;
}
__device__ __forceinline__ void xcd_barrier_complete(unsigned* bar, unsigned x, unsigned& nloc, unsigned& nx) {
    const unsigned G = gridDim.x * gridDim.y * gridDim.z;
    unsigned sum, cnt, mine, sp = 0u;
    for (;;) {
        sum = 0u; cnt = 0u; mine = 0u;
#pragma unroll
        for (unsigned j = 0; j < 16; ++j) { const unsigned c = xb_ld(&bar[XB_XCNT(j)]); sum += c; cnt += (c > 0u) ? 1u : 0u; mine = (j == x) ? c : mine; }
        if (sum == G) break;
        __builtin_amdgcn_s_sleep(1);
        if ((++sp & 255u) == 0u) { if (xb_ld(&bar[XB_TMO])) break; if (sp > XB_SPIN_CAP) { atomicAdd(&bar[XB_TMO], 1u); break; } }
    }
    nloc = mine > 0u ? mine : 1u; nx = cnt > 0u ? cnt : 1u;
}
__device__ __forceinline__ void xcd_barrier(const XcdBarrier& b) {
    asm volatile("s_waitcnt vmcnt(0)" ::: "memory");
    __syncthreads();
    if (threadIdx.x == 0) {
        unsigned* bar = b.bar;
        __builtin_amdgcn_s_waitcnt(0);
        unsigned nloc = b.st[0], nx = b.st[1];
        if (nloc == 0u) { xcd_barrier_complete(bar, b.x, nloc, nx); b.st[0] = nloc; b.st[1] = nx; }
        const unsigned old = xb_add(&bar[XB_XSUB(b.x)], 1u);
        const unsigned gen = old / nloc;
        if (old + 1u == (gen + 1u) * nloc) {
            __builtin_amdgcn_fence(__ATOMIC_RELEASE, "agent");
            asm volatile("s_waitcnt vmcnt(0)" ::: "memory");
            const unsigned og = xb_add(&bar[XB_TOP], 1u);
            const unsigned tg = og / nx;
            if (og + 1u == (tg + 1u) * nx) xb_add(&bar[XB_TOPGEN], 1u);
            else XB_SPIN(xb_ld(&bar[XB_TOPGEN]) == tg, bar);
            __builtin_amdgcn_fence(__ATOMIC_ACQUIRE, "agent");
            xb_add(&bar[XB_XGEN(b.x)], 1u);
            asm volatile("s_waitcnt vmcnt(0)" ::: "memory");
        } else {
            XB_SPIN(xb_ld(&bar[XB_XGEN(b.x)]) == gen, bar);
            __builtin_amdgcn_fence(__ATOMIC_ACQUIRE, "agent");
            asm volatile("s_waitcnt vmcnt(0)" ::: "memory");
        }
    }
    __syncthreads();
}

constexpr int NWAVES = 8;
constexpr int NB = 2, SEQ = 8192, DM = 1024, NMETA = 16, LSEQ = SEQ + NMETA;
constexpr int TR = NB * SEQ;
constexpr int MROWS = TR + 256;
constexpr int LP = 64 + SEQ;
constexpr int ARROWS = NB * LP;
constexpr int DIN = 4392, NIN = 4608;
constexpr int NEXP = 32, FE = 256;
constexpr float EPSN = 1e-6f;
constexpr float LOG2E = 1.4426950408889634f;
constexpr float QS_MLA = 0.10206207261596575f * LOG2E;
constexpr float QS_FOX = 0.125f * LOG2E;
constexpr float BIG = 1e30f;

constexpr size_t MiB = 1u << 20;
constexpr size_t WS_CTL = 0, CTL_ZERO_BYTES = 1 * MiB;
constexpr size_t WS_SSQQ = 1 * MiB, WS_SSQKV = 1 * MiB + 512 * 1024;
constexpr size_t WS_COS = 2 * MiB, WS_SIN = 3 * MiB, WS_FL = 4 * MiB, WS_CB = 5 * MiB, WS_BIAS0 = 5 * MiB + 768 * 1024, WS_KNMAX = 5 * MiB + 896 * 1024, WS_KR = 6 * MiB, WS_RT = 9 * MiB;
constexpr size_t WS_WIN = 12 * MiB, WS_WQUP = 21 * MiB, WS_WKVUP = 22 * MiB, WS_WA = 23 * MiB, WS_WB = 24 * MiB, WS_WOUT = 25 * MiB, WS_WUP = 27 * MiB, WS_WD = 59 * MiB;
constexpr size_t WS_U = 75 * MiB, WS_CQ = 108 * MiB, WS_CKV = 125 * MiB, WS_FQ = 134 * MiB, WS_FK = 151 * MiB, WS_FV = 168 * MiB, WS_QM = 185 * MiB, WS_KM = 210 * MiB, WS_VM = 235 * MiB, WS_END = 252 * MiB;
constexpr size_t WS_Y = WS_U, WS_MERGED = 134 * MiB, WS_T = 166 * MiB, WS_HM = 108 * MiB, WS_YE = 128 * MiB;
static_assert(WS_U + (size_t)MROWS * DM * 2 <= WS_CQ && WS_CQ + (size_t)MROWS * 512 * 2 <= WS_CKV && WS_CKV + (size_t)MROWS * 256 * 2 <= WS_FQ, "ws map 1");
static_assert(WS_FQ + (size_t)ARROWS * 512 * 2 <= WS_FK && WS_FV + (size_t)ARROWS * 512 * 2 <= WS_QM && WS_QM + (size_t)ARROWS * 768 * 2 <= WS_KM && WS_KM + (size_t)ARROWS * 768 * 2 <= WS_VM && WS_VM + (size_t)ARROWS * 512 * 2 <= WS_END, "ws map 2");
static_assert(WS_WIN + (size_t)NIN * DM * 2 <= WS_WQUP && WS_WUP + (size_t)NEXP * 512 * 1024 * 2 <= WS_WD && WS_WD + (size_t)NEXP * 1024 * 256 * 2 <= WS_U, "ws map 3");
constexpr int CW_BAR = 4096;

constexpr int RING_OFF = 0, RING_BYTES = 131072, LDS_BYTES = 163840, LDSCTL_OFF = LDS_BYTES - 1024, MISC_OFF = LDSCTL_OFF + 320;

typedef unsigned short bf16;
typedef unsigned v4u __attribute__((ext_vector_type(4)));
typedef float f32x4 __attribute__((ext_vector_type(4)));
#define LDS_WAIT() asm volatile("s_waitcnt lgkmcnt(0)" ::: "memory")
#define VM_WAIT() asm volatile("s_waitcnt vmcnt(0)" ::: "memory")
__device__ __forceinline__ unsigned f2bf(float f) { unsigned u = __builtin_bit_cast(unsigned, f); return (u + 0x7fffu + ((u >> 16) & 1u)) >> 16; }
__device__ __forceinline__ unsigned pk2(float lo, float hi) { return f2bf(lo) | (f2bf(hi) << 16); }
__device__ __forceinline__ float bf2f(unsigned short v) { return __builtin_bit_cast(float, (unsigned)v << 16); }
__device__ __forceinline__ float wave_sum(float v) {
#pragma unroll
    for (int o = 1; o < 64; o <<= 1) v += __shfl_xor(v, o);
    return v;
}

struct Ptrs {
    const float* in[21]; float* out; unsigned char* ws; int ph_lo, ph_hi;
};
struct Frame {
    LAS unsigned char* lds; volatile LAS unsigned* MISC; unsigned* ctl;
    int tid, lane, wave, vcu, G;
};

__device__ __forceinline__ int srccol_in(int n) {
    if (n < 768) return n;
    if (n < 2304) return n + 32;
    if (n < 4352) return n + 40;
    if (n < 4384) { const int j = n - 4352, i = j >> 1; return 768 + ((j & 1) ? 16 + i : i); }
    if (n < 4392) return 2336 + (n - 4384);
    return -1;
}
__device__ __forceinline__ int srccol_q(int n) { const int h = n / 96, d = n % 96; if (d < 64) return n; const int j = d - 64, i = j >> 1; return h * 96 + 64 + ((j & 1) ? 16 + i : i); }

constexpr int NTILE = LP / 64;
template <int NCH> __device__ __forceinline__ size_t kimg_off(int bh, int ap, int chunk) { return ((size_t)(bh * NTILE + (ap >> 6)) * NCH + chunk) * 512 + (ap & 63) * 8; }
__device__ __forceinline__ size_t vimg_off(int bh, int ap, int d) { return ((size_t)(bh * NTILE + (ap >> 6)) * 2 + (d >> 5)) * 2048 + (ap & 63) * 32 + (d & 31); }
template <class Src>
__device__ __forceinline__ void transpose_item(const Src& src, int K, bf16* WT, LAS float* scr, int k0, int n0, int lane) {
#pragma unroll 8
    for (int i = 0; i < 32; ++i) { const int kk = 2 * i + (lane >> 5); scr[kk * 33 + (lane & 31)] = src(k0 + kk, n0 + (lane & 31)); }
    LDS_WAIT(); asm volatile("" ::: "memory");
    const int c = lane & 7;
#pragma unroll
    for (int j = 0; j < 4; ++j) { const int n = (lane >> 3) + 8 * j; const LAS float* s = scr + (8 * c) * 33 + n;
        v4u o; o.x = pk2(s[0 * 33], s[1 * 33]); o.y = pk2(s[2 * 33], s[3 * 33]); o.z = pk2(s[4 * 33], s[5 * 33]); o.w = pk2(s[6 * 33], s[7 * 33]);
        *(v4u*)(WT + (size_t)(n0 + n) * K + k0 + 8 * c) = o; }
    LDS_WAIT(); asm volatile("" ::: "memory");
}
struct SrcIn { const float* w; __device__ __forceinline__ float operator()(int k, int n) const { const int c = srccol_in(n); return c < 0 ? 0.f : w[(size_t)k * DIN + c]; } };
struct SrcQ { const float* w; const float* g; __device__ __forceinline__ float operator()(int k, int n) const { return g[k] * w[(size_t)k * 768 + srccol_q(n)]; } };
struct SrcKV { const float* w; const float* g; __device__ __forceinline__ float operator()(int k, int n) const { return g[k] * w[(size_t)k * 1024 + n]; } };
struct SrcPlain { const float* w; int N; __device__ __forceinline__ float operator()(int k, int n) const { return w[(size_t)k * N + n]; } };
struct SrcUp { const float* wg; long du; __device__ __forceinline__ float operator()(int k, int n) const { const int f = (n >> 8) * 128 + (n & 127); return (wg + (long)((n >> 7) & 1) * du)[(size_t)k * FE + f]; } };

__device__ __forceinline__ void p0_prologue(const Frame& F, const Ptrs& P) {
    LAS float* scr = (LAS float*)(F.lds + RING_OFF + F.wave * 16384);
    const int gw = F.vcu * NWAVES + F.wave, NGW = F.G * NWAVES, lane = F.lane;
    unsigned char* ws = P.ws;
    {
        const float* x = P.in[0]; const float* meta = P.in[1]; const float* g = P.in[2]; bf16* U = (bf16*)(ws + WS_U);
        f32x4 gv[4];
#pragma unroll
        for (int j = 0; j < 4; ++j) gv[j] = ((const f32x4*)g)[lane + 64 * j];
        for (int m = gw; m < MROWS; m += NGW) {
            unsigned long long* o8 = (unsigned long long*)(U + (size_t)m * DM) + lane;
            if (m >= TR + NMETA) {
#pragma unroll
                for (int j = 0; j < 4; ++j) o8[64 * j] = 0ull;
                continue; }
            const f32x4* xr = (const f32x4*)(m < TR ? x + (size_t)m * DM : meta + (size_t)(m - TR) * DM) + lane;
            f32x4 v[4]; float s = 0.f;
#pragma unroll
            for (int j = 0; j < 4; ++j) { v[j] = xr[64 * j]; s += (v[j].x * v[j].x + v[j].y * v[j].y) + (v[j].z * v[j].z + v[j].w * v[j].w); }
            const float rstd = 1.f / sqrtf(wave_sum(s) * (1.f / DM) + EPSN);
#pragma unroll
            for (int j = 0; j < 4; ++j) { const f32x4 w = v[j] * rstd * gv[j]; o8[64 * j] = (unsigned long long)pk2(w.x, w.y) | ((unsigned long long)pk2(w.z, w.w) << 32); }
        }
    }
    {
        constexpr int I_IN = (DM / 64) * (NIN / 32), I_Q = (512 / 64) * (768 / 32), I_KV = (256 / 64) * (1024 / 32), I_AB = (512 / 64) * (1024 / 32), I_O = (1024 / 64) * (1024 / 32);
        constexpr int I_UP1 = (1024 / 64) * (512 / 32), I_UP = NEXP * I_UP1, I_D1 = (256 / 64) * (1024 / 32), I_DN = NEXP * I_D1;
        constexpr int NITEMS = I_IN + I_Q + I_KV + 2 * I_AB + I_O + I_UP + I_DN;
        for (int it = gw; it < NITEMS; it += NGW) {
            int r = it;
            if (r < I_IN) { const int nb = NIN / 32; transpose_item(SrcIn{P.in[3]}, DM, (bf16*)(ws + WS_WIN), scr, 64 * (r / nb), 32 * (r % nb), lane); continue; } r -= I_IN;
            if (r < I_Q) { const int nb = 768 / 32; transpose_item(SrcQ{P.in[6], P.in[5]}, 512, (bf16*)(ws + WS_WQUP), scr, 64 * (r / nb), 32 * (r % nb), lane); continue; } r -= I_Q;
            if (r < I_KV) { const int nb = 1024 / 32; transpose_item(SrcKV{P.in[8], P.in[7]}, 256, (bf16*)(ws + WS_WKVUP), scr, 64 * (r / nb), 32 * (r % nb), lane); continue; } r -= I_KV;
            if (r < I_AB) { const int nb = 32; transpose_item(SrcPlain{P.in[9], 1024}, 512, (bf16*)(ws + WS_WA), scr, 64 * (r / nb), 32 * (r % nb), lane); continue; } r -= I_AB;
            if (r < I_AB) { const int nb = 32; transpose_item(SrcPlain{P.in[10], 1024}, 512, (bf16*)(ws + WS_WB), scr, 64 * (r / nb), 32 * (r % nb), lane); continue; } r -= I_AB;
            if (r < I_O) { const int nb = 32; transpose_item(SrcPlain{P.in[11], 1024}, 1024, (bf16*)(ws + WS_WOUT), scr, 64 * (r / nb), 32 * (r % nb), lane); continue; } r -= I_O;
            if (r < I_UP) { const int e = r / I_UP1, q = r % I_UP1, nb = 512 / 32;
                transpose_item(SrcUp{P.in[17] + (size_t)e * 1024 * FE, (long)(P.in[18] - P.in[17])}, 1024, (bf16*)(ws + WS_WUP) + (size_t)e * 512 * 1024, scr, 64 * (q / nb), 32 * (q % nb), lane); continue; } r -= I_UP;
            { const int e = r / I_D1, q = r % I_D1, nb = 1024 / 32;
                transpose_item(SrcPlain{P.in[19] + (size_t)e * FE * 1024, 1024}, 256, (bf16*)(ws + WS_WD) + (size_t)e * 1024 * 256, scr, 64 * (q / nb), 32 * (q % nb), lane); }
        }
    }
    {
        const int gt = F.vcu * (NWAVES * 64) + F.tid, NGT = F.G * NWAVES * 64;
        float* ct = (float*)(ws + WS_COS); float* st = (float*)(ws + WS_SIN);
        for (int i = gt; i < LSEQ * 16; i += NGT) { const int p = i >> 4, j = i & 15;
            const double ang = (double)p * pow(10000.0, -(double)j / 16.0);
            ct[i] = (float)cos(ang); st[i] = (float)sin(ang); }
        float* sq = (float*)(ws + WS_SSQQ); float* skv = (float*)(ws + WS_SSQKV);
        for (int i = gt; i < MROWS; i += NGT) { sq[i] = 0.f; skv[i] = 0.f; }
        float* b0 = (float*)(ws + WS_BIAS0);
        for (int i = gt; i < 64; i += NGT) b0[i] = i < NMETA ? 0.f : BIG;
        for (int i = gt; i < 16 * 48 * (8 + 12 + 8 + 8); i += NGT) {
            const int per = 36, rr = i / per, c = i % per, bh = rr / 48, row = 16 + rr % 48;
            bf16* dst;
            if (c < 8) dst = (bf16*)(ws + WS_FK) + kimg_off<8>(bh, row, c);
            else if (c < 20) dst = (bf16*)(ws + WS_KM) + kimg_off<12>(bh, row, c - 8);
            else if (c < 28) dst = (bf16*)(ws + WS_FV) + vimg_off(bh, row, (c - 20) * 8);
            else dst = (bf16*)(ws + WS_VM) + vimg_off(bh, row, (c - 28) * 8);
            *(v4u*)dst = (v4u){0u, 0u, 0u, 0u}; }
    }
}

struct DenseOrder {
    int nM, nN, nwg, G, c;
    __device__ __forceinline__ void init(int nM_, int nN_, int G_, int c_) { nM = nM_; nN = nN_; nwg = nM * nN; G = G_; c = c_; }
    __device__ __forceinline__ bool next(int i, pg8::Unit& u) const {
        const long L = (long)i * G + c; if (L >= nwg) return false;
        int wgid = (int)L; { const int q = nwg / 8, r = nwg % 8, xcd = wgid % 8, off = wgid / 8; wgid = (xcd < r ? xcd * (q + 1) : r * (q + 1) + (xcd - r) * q) + off; }
        const int nig = 8 * nN, gid = wgid / nig, fm = gid * 8, gsz = (nM - fm) < 8 ? (nM - fm) : 8;
        u.pm = fm + ((wgid % nig) % gsz); u.pn = (wgid % nig) / gsz; u.be = 0; return true;
    }
};
__device__ __forceinline__ int arow_of(int m) { return (m >> 13) * LP + 64 + (m & (SEQ - 1)); }
__device__ __forceinline__ float sigmoid_fast(float x) { return __builtin_amdgcn_rcpf(1.f + __builtin_amdgcn_exp2f(-LOG2E * x)); }

struct EpiP1 {
    static constexpr bool PERM = true;
    unsigned char* ws; bf16* SG;
    __device__ __forceinline__ void operator()(const pg8::f32x4 (&acc)[2][2][4][2], const pg8::Unit& u, int wr, int wc, int fr, int fq) const {
        const int pn = u.pn;
#pragma unroll
        for (int ai = 0; ai < 2; ++ai)
#pragma unroll
            for (int m = 0; m < 4; ++m) {
                const int r = u.pm * 256 + ai * 128 + wr * 64 + m * 16 + fr;
                const int c8 = wc * 32 + 8 * fq;
                if (pn < 3) {
                    float s = 0.f;
                    const size_t off = pn < 2 ? WS_CQ + ((size_t)r * 512 + pn * 256 + c8) * 2 : WS_CKV + ((size_t)r * 256 + c8) * 2;
#pragma unroll
                    for (int bj = 0; bj < 2; ++bj) { const pg8::f32x4 v0 = acc[ai][bj][m][0], v1 = acc[ai][bj][m][1];
                        s += (v0[0] * v0[0] + v0[1] * v0[1]) + (v0[2] * v0[2] + v0[3] * v0[3]) + (v1[0] * v1[0] + v1[1] * v1[1]) + (v1[2] * v1[2] + v1[3] * v1[3]);
                        *(pg8::u32x4*)(ws + off + bj * 256) = pg8::pack8(v0, v1); }
                    s += __shfl_xor(s, 16); s += __shfl_xor(s, 32);
                    if (fq == 0) atomicAdd((float*)(ws + (pn < 2 ? WS_SSQQ : WS_SSQKV)) + r, s);
                } else if (pn < 9) {
                    const int seg = (pn - 3) >> 1, cb = ((pn - 3) & 1) * 256;
                    if (r < TR + NMETA) {
                        const int b0 = r < TR ? (r >> 13) : 0, ap = r < TR ? 64 + (r & (SEQ - 1)) : r - TR;
#pragma unroll
                        for (int bj = 0; bj < 2; ++bj) { const int cc = cb + bj * 128 + c8, h = cc >> 6, d = cc & 63;
                            if (seg == 0) { const pg8::u32x4 w = pg8::pack8(acc[ai][bj][m][0] * QS_FOX, acc[ai][bj][m][1] * QS_FOX);
                                if (r < TR) *(pg8::u32x4*)(ws + WS_FQ + ((size_t)(b0 * LP + ap) * 512 + cc) * 2) = w; }
                            else { const pg8::u32x4 w = pg8::pack8(acc[ai][bj][m][0], acc[ai][bj][m][1]);
                                const size_t o = seg == 1 ? WS_FK + kimg_off<8>(b0 * 8 + h, ap, d >> 3) * 2 : WS_FV + vimg_off(b0 * 8 + h, ap, d) * 2;
                                const size_t bstep = seg == 1 ? kimg_off<8>(8, 0, 0) * 2 : vimg_off(8, 0, 0) * 2;
                                *(pg8::u32x4*)(ws + o) = w; if (r >= TR) *(pg8::u32x4*)(ws + o + bstep) = w; } }
                    }
                } else if (pn < 17) {
                    if (r < TR) {
                        bf16* base = SG + (size_t)((pn - 9) >> 2) * TR * 1024 + (size_t)r * 1024 + ((pn - 9) & 3) * 256 + c8;
#pragma unroll
                        for (int bj = 0; bj < 2; ++bj) { pg8::f32x4 v0 = acc[ai][bj][m][0], v1 = acc[ai][bj][m][1];
#pragma unroll
                            for (int e = 0; e < 4; ++e) { v0[e] = sigmoid_fast(v0[e]); v1[e] = sigmoid_fast(v1[e]); }
                            *(pg8::u32x4*)(base + bj * 128) = pg8::pack8(v0, v1); }
                    }
                } else {
                    if (c8 < 32) { float* d = (float*)(ws + WS_KR) + (size_t)r * 32 + c8; *(pg8::f32x4*)d = acc[ai][0][m][0]; *(pg8::f32x4*)(d + 4) = acc[ai][0][m][1]; }
                    else if (c8 == 32) { float* d = (float*)(ws + WS_FL) + (size_t)r * 8; *(pg8::f32x4*)d = acc[ai][0][m][0]; *(pg8::f32x4*)(d + 4) = acc[ai][0][m][1]; }
                }
            }
    }
};

struct EpiQ {
    static constexpr bool PERM = true;
    unsigned char* ws;
    __device__ __forceinline__ void operator()(const pg8::f32x4 (&acc)[2][2][4][2], const pg8::Unit& u, int wr, int wc, int fr, int fq) const {
        const float* SSQ = (const float*)(ws + WS_SSQQ); const float* ct = (const float*)(ws + WS_COS); const float* st = (const float*)(ws + WS_SIN); bf16* QM = (bf16*)(ws + WS_QM);
#pragma unroll
        for (int ai = 0; ai < 2; ++ai)
#pragma unroll
            for (int m = 0; m < 4; ++m) {
                const int r = u.pm * 256 + ai * 128 + wr * 64 + m * 16 + fr;
                const float sc = QS_MLA / sqrtf(SSQ[r] * (1.f / 512.f) + EPSN);
                const int pos = (r & (SEQ - 1)) + NMETA;
                bf16* orow = QM + (size_t)arow_of(r) * 768;
#pragma unroll
                for (int bj = 0; bj < 2; ++bj) {
                    const int c = u.pn * 256 + bj * 128 + wc * 32 + 8 * fq, d = c % 96;
                    pg8::f32x4 v0 = acc[ai][bj][m][0] * sc, v1 = acc[ai][bj][m][1] * sc;
                    if (d >= 64) {
                        const int i0 = (d - 64) >> 1;
                        const pg8::f32x4 cs = *(const pg8::f32x4*)(ct + pos * 16 + i0), sn = *(const pg8::f32x4*)(st + pos * 16 + i0);
                        pg8::f32x4 o0, o1;
                        o0[0] = v0[0] * cs[0] - v0[1] * sn[0]; o0[1] = v0[0] * sn[0] + v0[1] * cs[0];
                        o0[2] = v0[2] * cs[1] - v0[3] * sn[1]; o0[3] = v0[2] * sn[1] + v0[3] * cs[1];
                        o1[0] = v1[0] * cs[2] - v1[1] * sn[2]; o1[1] = v1[0] * sn[2] + v1[1] * cs[2];
                        o1[2] = v1[2] * cs[3] - v1[3] * sn[3]; o1[3] = v1[2] * sn[3] + v1[3] * cs[3];
                        v0 = o0; v1 = o1;
                    }
                    *(pg8::u32x4*)(orow + c) = pg8::pack8(v0, v1);
                }
            }
    }
};
struct EpiKV {
    static constexpr bool PERM = true;
    unsigned char* ws;
    __device__ __forceinline__ void operator()(const pg8::f32x4 (&acc)[2][2][4][2], const pg8::Unit& u, int wr, int wc, int fr, int fq) const {
        const float* SSKV = (const float*)(ws + WS_SSQKV);
#pragma unroll
        for (int ai = 0; ai < 2; ++ai)
#pragma unroll
            for (int m = 0; m < 4; ++m) {
                const int r = u.pm * 256 + ai * 128 + wr * 64 + m * 16 + fr;
                if (r >= TR + NMETA) continue;
                const float sc = 1.f / sqrtf(SSKV[r] * (1.f / 256.f) + EPSN);
                const int b0 = r < TR ? (r >> 13) : 0, ap = r < TR ? 64 + (r & (SEQ - 1)) : r - TR;
                const int j = wc * 32 + 8 * fq;
#pragma unroll
                for (int bj = 0; bj < 2; ++bj) {
                    const int h = u.pn * 2 + bj;
                    const pg8::u32x4 w = pg8::pack8(acc[ai][bj][m][0] * sc, acc[ai][bj][m][1] * sc);
                    const size_t o = j < 64 ? WS_KM + kimg_off<12>(b0 * 8 + h, ap, j >> 3) * 2 : WS_VM + vimg_off(b0 * 8 + h, ap, j - 64) * 2;
                    const size_t bstep = j < 64 ? kimg_off<12>(8, 0, 0) * 2 : vimg_off(8, 0, 0) * 2;
                    *(pg8::u32x4*)(ws + o) = w;
                    if (r >= TR) *(pg8::u32x4*)(ws + o + bstep) = w;
                }
            }
    }
};
__device__ __forceinline__ float log2sig(float z) {
    const float t = exp2f(-fabsf(z) * LOG2E);
    return fminf(z, 0.f) * LOG2E - log2f(1.f + t);
}
__device__ __forceinline__ void p2_small(const Frame& F, const Ptrs& P) {
    unsigned char* ws = P.ws;
    {
        const int gt = F.vcu * (NWAVES * 64) + F.tid, NGT = F.G * NWAVES * 64;
        const float* KR = (const float*)(ws + WS_KR); const float* ct = (const float*)(ws + WS_COS); const float* st = (const float*)(ws + WS_SIN); bf16* KM = (bf16*)(ws + WS_KM);
        for (int i = gt; i < (TR + NMETA) * 4; i += NGT) {
            const int m = i >> 2, q = i & 3, pos = m < TR ? (m & (SEQ - 1)) + NMETA : m - TR, b0 = m < TR ? (m >> 13) : 0, ap = m < TR ? 64 + (m & (SEQ - 1)) : m - TR;
            const f32x4 v0 = *(const f32x4*)(KR + (size_t)m * 32 + q * 8), v1 = *(const f32x4*)(KR + (size_t)m * 32 + q * 8 + 4);
            const f32x4 cs = *(const f32x4*)(ct + pos * 16 + q * 4), sn = *(const f32x4*)(st + pos * 16 + q * 4);
            v4u w;
            w.x = pk2(v0[0] * cs[0] - v0[1] * sn[0], v0[0] * sn[0] + v0[1] * cs[0]); w.y = pk2(v0[2] * cs[1] - v0[3] * sn[1], v0[2] * sn[1] + v0[3] * cs[1]);
            w.z = pk2(v1[0] * cs[2] - v1[1] * sn[2], v1[0] * sn[2] + v1[1] * cs[2]); w.w = pk2(v1[2] * cs[3] - v1[3] * sn[3], v1[2] * sn[3] + v1[3] * cs[3]);
#pragma unroll
            for (int h = 0; h < 8; ++h) { bf16* d = KM + kimg_off<12>(b0 * 8 + h, ap, 8 + q); *(v4u*)d = w; if (m >= TR) *(v4u*)(d + kimg_off<12>(8, 0, 0)) = w; }
        }
    }
    if (F.vcu < NB * 8) {
        const int b = F.vcu >> 3, h = F.vcu & 7, tid = F.tid;
        const float* FL = (const float*)(ws + WS_FL); const float bfh = P.in[4][h]; float* CB = (float*)(ws + WS_CB) + (size_t)(b * 8 + h) * LP;
        LAS float* sh = (LAS float*)(F.lds + RING_OFF);
        constexpr int PER = 17;
        float v[PER]; float run = 0.f;
#pragma unroll
        for (int k = 0; k < PER; ++k) { const int p = tid * PER + k; float x = 0.f;
            if (p < LSEQ) { const int m = p < NMETA ? TR + p : b * SEQ + (p - NMETA); x = log2sig(FL[(size_t)m * 8 + h] + bfh); }
            run += x; v[k] = run; }
        float incl = run;
#pragma unroll
        for (int o = 1; o < 64; o <<= 1) { const float t = __shfl_up(incl, o); if (F.lane >= o) incl += t; }
        if (F.lane == 63) sh[F.wave] = incl;
        LDS_WAIT(); __syncthreads();
        float base = incl - run;
        for (int w = 0; w < F.wave; ++w) base += sh[w];
#pragma unroll
        for (int k = 0; k < PER; ++k) { const int p = tid * PER + k; if (p < LSEQ) CB[p < NMETA ? p : 48 + p] = base + v[k]; }
        if (tid < 48) CB[16 + tid] = BIG;
        __syncthreads();
        { const bf16* FK = (const bf16*)(ws + WS_FK); float mx = 0.f;
          for (int r = tid; r < LP; r += NWAVES * 64) { float ss = 0.f;
#pragma unroll
              for (int c = 0; c < 8; ++c) { const v4u w = *(const v4u*)(FK + kimg_off<8>(b * 8 + h, r, c));
#pragma unroll
                  for (int e = 0; e < 4; ++e) { const float lo = __builtin_bit_cast(float, w[e] << 16), hi2 = __builtin_bit_cast(float, w[e] & 0xffff0000u); ss += lo * lo + hi2 * hi2; } }
              mx = fmaxf(mx, ss); }
#pragma unroll
          for (int o = 1; o < 64; o <<= 1) mx = fmaxf(mx, __shfl_xor(mx, o));
          if (F.lane == 0) sh[8 + F.wave] = mx;
          LDS_WAIT(); __syncthreads();
          if (tid == 0) { float m2 = 0.f; for (int w = 0; w < NWAVES; ++w) m2 = fmaxf(m2, sh[8 + w]); ((float*)(ws + WS_KNMAX))[b * 8 + h] = sqrtf(m2); }
          __syncthreads(); }
    }
}

namespace att {
typedef short bf16x8 __attribute__((ext_vector_type(8)));
typedef short s16x4 __attribute__((ext_vector_type(4)));
typedef float f32x16 __attribute__((ext_vector_type(16)));
typedef unsigned u32x4 __attribute__((ext_vector_type(4)));
typedef float f32x2_t __attribute__((ext_vector_type(2)));
typedef __bf16 bf16x2_t __attribute__((ext_vector_type(2)));
typedef short v4i16_t __attribute__((ext_vector_type(4)));
__device__ __forceinline__ int crow(int r, int hi) { return (r & 3) + 8 * (r >> 2) + 4 * hi; }
__device__ __forceinline__ unsigned cvtpk_s(float lo, float hi) { f32x2_t v = {lo, hi}; bf16x2_t b = __builtin_convertvector(v, bf16x2_t); return __builtin_bit_cast(unsigned, b); }
__device__ __forceinline__ s16x4 vtr(LAS const char* p) { return __builtin_bit_cast(s16x4, __builtin_amdgcn_ds_read_tr16_b64_v4i16((LAS v4i16_t*)p)); }
#define ATT_MX3(a, b, c) __builtin_fmaxf(__builtin_fmaxf((a), (b)), (c))
__device__ __forceinline__ float rowmax(const f32x16& p0, const f32x16& p1) {
    float a = ATT_MX3(p0[0], p0[1], p1[0]), b = ATT_MX3(p0[2], p0[3], p1[1]); a = ATT_MX3(a, p1[2], p1[3]);
#pragma unroll
    for (int r = 4; r < 16; r += 4) { a = ATT_MX3(a, p0[r], p0[r + 1]); b = ATT_MX3(b, p0[r + 2], p0[r + 3]); a = ATT_MX3(a, p1[r], p1[r + 1]); b = ATT_MX3(b, p1[r + 2], p1[r + 3]); }
    float m = __builtin_fmaxf(a, b); auto rr = __builtin_amdgcn_permlane32_swap(__float_as_uint(m), __float_as_uint(m), false, false);
    return __builtin_fmaxf(__uint_as_float(rr[0]), __uint_as_float(rr[1])); }
__device__ __forceinline__ void cmask(f32x16& p0, f32x16& p1, int jb, int qrel, int hi) {
    const int kb = 64 * jb + 4 * hi;
#pragma unroll
    for (int r = 0; r < 16; ++r) { const int kv = kb + (r & 3) + 8 * (r >> 2); if (kv > qrel) p0[r] = -INFINITY; if (kv + 32 > qrel) p1[r] = -INFINITY; } }

template <int DK> struct Lay {
    static constexpr int KB = 64 * DK * 2;
    static constexpr int K0 = 0, V0 = 2 * KB, BI = V0 + 2 * 8192, VT = BI + 512, WS = VT + 64, OST = WS + NWAVES * 256, BYTES = OST + NWAVES * 4096;
};
struct Tens { const bf16* Q; int qp; const bf16* K; int kp; const bf16* V; const float* bias; bf16* Y; int ycol; const float* knmax; };

template <int DK, bool FOX, int THR>
__device__ __forceinline__ void attn_unit(int b, int h, int qb, const Tens T, LAS char* shm) {
    typedef Lay<DK> LY; constexpr int NDK = DK / 16;
    const int tid = threadIdx.x, lane = tid & 63, r32 = lane & 31, hi = lane >> 5; const int wid = __builtin_amdgcn_readfirstlane(tid >> 6);
    const long ab = (long)b * LP; const int q0 = 64 + qb * 256, NT = 4 * qb + 5;
    const bf16* Kh = T.K + kimg_off<DK / 8>(b * 8 + h, 0, 0); const bf16* Vh = T.V + vimg_off(b * 8 + h, 0, 0);
    const float* bias = FOX ? T.bias + (size_t)(b * 8 + h) * LP : T.bias;
    LAS float* wsf = (LAS float*)(shm + LY::WS) + wid * 64;
#define ATT_DMA(t, buf) do { \
        for (int c_ = wid; c_ < DK / 8; c_ += NWAVES) \
            __builtin_amdgcn_global_load_lds((const unsigned*)(Kh + ((size_t)(t) * (DK / 8) + c_) * 512 + lane * 8), (LAS unsigned*)(shm + LY::K0 + (buf) * LY::KB + c_ * 1024), 16, 0, 0); \
        __builtin_amdgcn_global_load_lds((const unsigned*)(Vh + ((size_t)(t) * 8 + wid) * 512 + lane * 8), (LAS unsigned*)(shm + LY::V0 + (buf) * 8192 + wid * 1024), 16, 0, 0); \
    } while (0)
    const bool bias_lane = (wid == 0 && lane < 16);
    constexpr float SKIP_T = 44.f;
#define ATT_TILE(tt) (FOX ? NT - 1 - (tt) : (tt))
    f32x4 bstage = (f32x4){0.f, 0.f, 0.f, 0.f};
    ATT_DMA(ATT_TILE(0), 0);
    if (bias_lane) bstage = *(const f32x4*)(bias + 64 * ATT_TILE(0) + lane * 4);
    bf16x8 qr[NDK];
    { const bf16* Qw = T.Q + (ab + q0 + wid * 32 + r32) * T.qp + h * DK + hi * 8;
#pragma unroll
      for (int d0 = 0; d0 < NDK; ++d0) qr[d0] = *(const bf16x8*)(Qw + d0 * 16); }
    float qk_bound = 0.f;
    if (FOX) { float ss = 0.f;
#pragma unroll
        for (int d0 = 0; d0 < NDK; ++d0)
#pragma unroll
            for (int e = 0; e < 8; ++e) { const float v = __builtin_bit_cast(float, (unsigned)(unsigned short)qr[d0][e] << 16); ss += v * v; }
        auto rr = __builtin_amdgcn_permlane32_swap(__float_as_uint(ss), __float_as_uint(ss), false, false); ss = __uint_as_float(rr[0]) + __uint_as_float(rr[1]);
        qk_bound = 1.01f * sqrtf(ss) * T.knmax[b * 8 + h]; }
    if (bias_lane) *(LAS f32x4*)(shm + LY::BI + lane * 16) = bstage;
    float mhat = 0.f, l_reg = 0.f; f32x16 o[2]; o[0] = f32x16{}; o[1] = f32x16{};
    const int qrel = wid * 32 + r32;
    bool first = true;
    asm volatile("s_waitcnt vmcnt(0) lgkmcnt(0)\n\ts_barrier" ::: "memory");
    for (int tt = 0; tt < NT; ++tt) {
        const int t = ATT_TILE(tt), buf = tt & 1;
        const bool more = tt + 1 < NT, nbias = more && (FOX);
        const int tn = ATT_TILE(tt + 1);
        if (more) ATT_DMA(tn, buf ^ 1);
        if (nbias && bias_lane) bstage = *(const f32x4*)(bias + 64 * tn + lane * 4);
        float cbend = 0.f; if (FOX && more) cbend = bias[tn ? 64 * tn + 63 : NMETA - 1];
        const int jb = t - (NT - 4);
        if (!(jb >= 0 && 64 * jb > 32 * wid + 31)) {
            f32x16 c0, c1; const float nm = -mhat;
            if (FOX || t == 0) {
                LAS const char* bp = shm + LY::BI + buf * 256 + hi * 16;
#pragma unroll
                for (int g = 0; g < 4; ++g) { const f32x4 b0 = *(LAS const f32x4*)(bp + g * 32), b1 = *(LAS const f32x4*)(bp + 128 + g * 32);
#pragma unroll
                    for (int e = 0; e < 4; ++e) { c0[4 * g + e] = nm - b0[e]; c1[4 * g + e] = nm - b1[e]; } }
            } else {
#pragma unroll
                for (int r = 0; r < 16; ++r) { c0[r] = nm; c1[r] = nm; }
            }
            LAS const char* kp0 = shm + LY::K0 + buf * LY::KB + hi * 1024 + r32 * 16;
#pragma unroll
            for (int d0 = 0; d0 < NDK; ++d0) {
                const bf16x8 k0 = *(LAS const bf16x8*)(kp0 + d0 * 2048), k1 = *(LAS const bf16x8*)(kp0 + d0 * 2048 + 512);
                c0 = __builtin_amdgcn_mfma_f32_32x32x16_bf16(k0, qr[d0], c0, 0, 0, 0);
                c1 = __builtin_amdgcn_mfma_f32_32x32x16_bf16(k1, qr[d0], c1, 0, 0, 0);
            }
            if (jb >= 0) cmask(c0, c1, jb, qrel, hi);
            const float rm = rowmax(c0, c1);
            if (first) {
                first = false; mhat += rm;
#pragma unroll
                for (int r = 0; r < 16; ++r) { c0[r] -= rm; c1[r] -= rm; }
            } else if (__any(rm > (float)THR)) {
                const float dl = __builtin_fmaxf(rm, 0.f); mhat += dl;
#pragma unroll
                for (int r = 0; r < 16; ++r) { c0[r] -= dl; c1[r] -= dl; }
                const float f = __builtin_amdgcn_exp2f(-dl); l_reg *= f;
                if (hi == 0) wsf[r32] = f;
                asm volatile("s_waitcnt lgkmcnt(0)" ::: "memory");
#pragma unroll
                for (int g = 0; g < 4; ++g) { const f32x4 fv = *(LAS const f32x4*)((LAS const char*)wsf + (8 * g + 4 * hi) * 4);
#pragma unroll
                    for (int e = 0; e < 4; ++e) { o[0][4 * g + e] *= fv[e]; o[1][4 * g + e] *= fv[e]; } }
            }
            float sacc = 0.f;
#pragma unroll
            for (int r = 0; r < 16; ++r) { c0[r] = __builtin_amdgcn_exp2f(c0[r]); c1[r] = __builtin_amdgcn_exp2f(c1[r]); sacc += c0[r] + c1[r]; }
            l_reg += sacc;
            u32x4 pw[4];
#pragma unroll
            for (int k = 0; k < 2; ++k)
#pragma unroll
                for (int e = 0; e < 4; ++e) { pw[k][e] = cvtpk_s(c0[8 * k + 2 * e], c0[8 * k + 2 * e + 1]); pw[2 + k][e] = cvtpk_s(c1[8 * k + 2 * e], c1[8 * k + 2 * e + 1]); }
            LAS const char* vp0 = shm + LY::V0 + buf * 8192 + ((lane >> 4) & 1) * 32 + (lane & 3) * 8 + (4 * hi + ((lane & 15) >> 2)) * 64;
#pragma unroll
            for (int d0 = 0; d0 < 2; ++d0)
#pragma unroll
                for (int ks = 0; ks < 4; ++ks) {
                    const s16x4 lo = vtr(vp0 + d0 * 4096 + ks * 1024), hh = vtr(vp0 + d0 * 4096 + ks * 1024 + 512);
                    const bf16x8 vf = (bf16x8){lo[0], lo[1], lo[2], lo[3], hh[0], hh[1], hh[2], hh[3]};
                    o[d0] = __builtin_amdgcn_mfma_f32_32x32x16_bf16(__builtin_bit_cast(bf16x8, pw[ks]), vf, o[d0], 0, 0, 0);
                }
        }
        if (nbias && bias_lane) *(LAS f32x4*)(shm + LY::BI + (buf ^ 1) * 256 + lane * 16) = bstage;
        if (FOX) {
            const bool need = first || __any(qk_bound - cbend - mhat > -SKIP_T);
            if (lane == 0) *(LAS int*)(shm + LY::VT + (buf * 8 + wid) * 4) = need ? 1 : 0;
        }
        asm volatile("s_waitcnt vmcnt(0) lgkmcnt(0)\n\ts_barrier" ::: "memory");
        if (FOX && more) {
            const f32x4 va = *(LAS const f32x4*)(shm + LY::VT + buf * 32), vb = *(LAS const f32x4*)(shm + LY::VT + buf * 32 + 16);
            const unsigned any = (__float_as_uint(va[0]) | __float_as_uint(va[1]) | __float_as_uint(va[2]) | __float_as_uint(va[3]) | __float_as_uint(vb[0]) | __float_as_uint(vb[1]) | __float_as_uint(vb[2]) | __float_as_uint(vb[3]));
            if (__builtin_amdgcn_readfirstlane(any) == 0u) break;
        }
    }
#undef ATT_TILE
    { auto rr = __builtin_amdgcn_permlane32_swap(__float_as_uint(l_reg), __float_as_uint(l_reg), false, false); l_reg = __uint_as_float(rr[0]) + __uint_as_float(rr[1]); }
    if (hi == 0) wsf[32 + r32] = l_reg;
    asm volatile("s_waitcnt lgkmcnt(0)" ::: "memory");
    float rli[16];
#pragma unroll
    for (int g = 0; g < 4; ++g) { const f32x4 lv = *(LAS const f32x4*)((LAS const char*)wsf + (32 + 8 * g + 4 * hi) * 4);
#pragma unroll
        for (int e = 0; e < 4; ++e) rli[4 * g + e] = __builtin_amdgcn_rcpf(lv[e]); }
    LAS unsigned short* stg = (LAS unsigned short*)(shm + LY::OST) + wid * 2048;
#pragma unroll
    for (int r = 0; r < 16; ++r) { const int orow = crow(r, hi);
#pragma unroll
        for (int d0 = 0; d0 < 2; ++d0) stg[orow * 64 + d0 * 32 + r32] = (unsigned short)f2bf(o[d0][r] * rli[r]); }
    asm volatile("s_waitcnt lgkmcnt(0)" ::: "memory");
    bf16* Ow = T.Y + ((size_t)b * SEQ + qb * 256 + wid * 32) * 1024 + T.ycol + h * 64;
#pragma unroll
    for (int i = 0; i < 4; ++i) { const int row = i * 8 + (lane >> 3), ch = lane & 7; const u32x4 v = *(LAS const u32x4*)(stg + row * 64 + ch * 8); *(u32x4*)(Ow + (size_t)row * 1024 + ch * 8) = v; }
    asm volatile("s_waitcnt lgkmcnt(0)\n\ts_barrier" ::: "memory");
#undef ATT_DMA
}
}

namespace att {
template <int THR>
__device__ __forceinline__ void mla_unit(int b, int h, int qb, const Tens T, LAS char* shm) {
    constexpr int DK = 96; typedef Lay<DK> LY; constexpr int NDK = 6;
    const int tid = threadIdx.x, lane = tid & 63, r32 = lane & 31, hi = lane >> 5; const int wid = __builtin_amdgcn_readfirstlane(tid >> 6);
    const long ab = (long)b * LP; const int q0 = 64 + qb * 256, NT = 4 * qb + 5;
    const bf16* Kh = T.K + kimg_off<12>(b * 8 + h, 0, 0); const bf16* Vh = T.V + vimg_off(b * 8 + h, 0, 0);
    LAS float* wsf = (LAS float*)(shm + LY::WS) + wid * 64;
#define ML_DMA(t, buf) do { \
        for (int c_ = wid; c_ < 12; c_ += NWAVES) \
            __builtin_amdgcn_global_load_lds((const unsigned*)(Kh + ((size_t)(t) * 12 + c_) * 512 + lane * 8), (LAS unsigned*)(shm + LY::K0 + (buf) * LY::KB + c_ * 1024), 16, 0, 0); \
        __builtin_amdgcn_global_load_lds((const unsigned*)(Vh + ((size_t)(t) * 8 + wid) * 512 + lane * 8), (LAS unsigned*)(shm + LY::V0 + (buf) * 8192 + wid * 1024), 16, 0, 0); \
    } while (0)
#define ML_WAITBAR() asm volatile("s_waitcnt vmcnt(0) lgkmcnt(0)\n\ts_barrier" ::: "memory")
    ML_DMA(0, 0);
    { int ln = lane; asm volatile("" : "+v"(ln));
      if (wid == 0 && ln < 16) { const f32x4 bv = *(const f32x4*)(T.bias + ln * 4); *(LAS f32x4*)(shm + LY::BI + ln * 16) = bv; } }
    bf16x8 qr[NDK];
    { const bf16* Qw = T.Q + (ab + q0 + wid * 32 + r32) * T.qp + h * DK + hi * 8;
#pragma unroll
      for (int d0 = 0; d0 < NDK; ++d0) qr[d0] = *(const bf16x8*)(Qw + d0 * 16); }
    float mhat = 0.f, l_reg = 0.f; f32x16 o[2]; o[0] = f32x16{}; o[1] = f32x16{};
    const int qrel = wid * 32 + r32;
    f32x16 negm = f32x16{};
    ML_WAITBAR();
#define ML_QK(buf, c0i, c1i) do { LAS const char* kp0 = shm + LY::K0 + (buf) * LY::KB + hi * 1024 + r32 * 16; bf16x8 kf[12]; \
        _Pragma("unroll") for (int d0 = 0; d0 < NDK; ++d0) { kf[2 * d0] = *(LAS const bf16x8*)(kp0 + d0 * 2048); kf[2 * d0 + 1] = *(LAS const bf16x8*)(kp0 + d0 * 2048 + 512); } \
        __builtin_amdgcn_sched_barrier(0); \
        c0 = __builtin_amdgcn_mfma_f32_32x32x16_bf16(kf[0], qr[0], c0i, 0, 0, 0); c1 = __builtin_amdgcn_mfma_f32_32x32x16_bf16(kf[1], qr[0], c1i, 0, 0, 0); \
        _Pragma("unroll") for (int d0 = 1; d0 < NDK; ++d0) { c0 = __builtin_amdgcn_mfma_f32_32x32x16_bf16(kf[2 * d0], qr[d0], c0, 0, 0, 0); c1 = __builtin_amdgcn_mfma_f32_32x32x16_bf16(kf[2 * d0 + 1], qr[d0], c1, 0, 0, 0); } \
    } while (0)
#define ML_PV(buf) do { float sacc = 0.f; \
        _Pragma("unroll") for (int r = 0; r < 16; ++r) { c0[r] = __builtin_amdgcn_exp2f(c0[r]); c1[r] = __builtin_amdgcn_exp2f(c1[r]); sacc += c0[r] + c1[r]; } \
        l_reg += sacc; u32x4 pw[4]; \
        _Pragma("unroll") for (int k = 0; k < 2; ++k) _Pragma("unroll") for (int e = 0; e < 4; ++e) { \
            pw[k][e] = cvtpk_s(c0[8 * k + 2 * e], c0[8 * k + 2 * e + 1]); pw[2 + k][e] = cvtpk_s(c1[8 * k + 2 * e], c1[8 * k + 2 * e + 1]); } \
        LAS const char* vp0 = shm + LY::V0 + (buf) * 8192 + ((lane >> 4) & 1) * 32 + (lane & 3) * 8 + (4 * hi + ((lane & 15) >> 2)) * 64; \
        _Pragma("unroll") for (int d0 = 0; d0 < 2; ++d0) { s16x4 lo[4], hh[4]; \
            _Pragma("unroll") for (int ks = 0; ks < 4; ++ks) { lo[ks] = vtr(vp0 + d0 * 4096 + ks * 1024); hh[ks] = vtr(vp0 + d0 * 4096 + ks * 1024 + 512); } \
            __builtin_amdgcn_sched_barrier(0); \
            _Pragma("unroll") for (int ks = 0; ks < 4; ++ks) { const bf16x8 vf = (bf16x8){lo[ks][0], lo[ks][1], lo[ks][2], lo[ks][3], hh[ks][0], hh[ks][1], hh[ks][2], hh[ks][3]}; \
                o[d0] = __builtin_amdgcn_mfma_f32_32x32x16_bf16(__builtin_bit_cast(bf16x8, pw[ks]), vf, o[d0], 0, 0, 0); } } \
    } while (0)
    f32x16 c0, c1;
    {
        if (NT > 1) ML_DMA(1, 1);
        f32x16 i0, i1;
        { LAS const char* bp = shm + LY::BI + hi * 16;
#pragma unroll
          for (int g = 0; g < 4; ++g) { const f32x4 b0 = *(LAS const f32x4*)(bp + g * 32), b1 = *(LAS const f32x4*)(bp + 128 + g * 32);
#pragma unroll
              for (int e = 0; e < 4; ++e) { i0[4 * g + e] = -b0[e]; i1[4 * g + e] = -b1[e]; } } }
        ML_QK(0, i0, i1);
        const float rm = rowmax(c0, c1); mhat = rm;
#pragma unroll
        for (int r = 0; r < 16; ++r) { c0[r] -= rm; c1[r] -= rm; negm[r] = -rm; }
        ML_PV(0);
        ML_WAITBAR();
    }
    for (int t = 1; t < NT; ++t) {
        const int buf = t & 1;
        if (t + 1 < NT) ML_DMA(t + 1, buf ^ 1);
        ML_QK(buf, negm, negm);
        const int jb = t - (NT - 4);
        if (jb >= 0) cmask(c0, c1, jb, qrel, hi);
        const float rm = rowmax(c0, c1);
        const bool need = __any(rm > (float)THR);
        const float dl = need ? __builtin_fmaxf(rm, 0.f) : 0.f;
#pragma unroll
        for (int r = 0; r < 16; ++r) { c0[r] -= dl; c1[r] -= dl; }
        if (need) {
            mhat += dl;
#pragma unroll
            for (int r = 0; r < 16; ++r) negm[r] = -mhat;
            const float f = __builtin_amdgcn_exp2f(-dl); l_reg *= f;
            if (hi == 0) wsf[r32] = f;
            asm volatile("s_waitcnt lgkmcnt(0)" ::: "memory");
#pragma unroll
            for (int g = 0; g < 4; ++g) { const f32x4 fv = *(LAS const f32x4*)((LAS const char*)wsf + (8 * g + 4 * hi) * 4);
#pragma unroll
                for (int e = 0; e < 4; ++e) { o[0][4 * g + e] *= fv[e]; o[1][4 * g + e] *= fv[e]; } }
        }
        ML_PV(buf);
        ML_WAITBAR();
    }
#undef ML_DMA
#undef ML_QK
#undef ML_PV
#undef ML_WAITBAR
    { auto rr = __builtin_amdgcn_permlane32_swap(__float_as_uint(l_reg), __float_as_uint(l_reg), false, false); l_reg = __uint_as_float(rr[0]) + __uint_as_float(rr[1]); }
    if (hi == 0) wsf[32 + r32] = l_reg;
    asm volatile("s_waitcnt lgkmcnt(0)" ::: "memory");
    float rli[16];
#pragma unroll
    for (int g = 0; g < 4; ++g) { const f32x4 lv = *(LAS const f32x4*)((LAS const char*)wsf + (32 + 8 * g + 4 * hi) * 4);
#pragma unroll
        for (int e = 0; e < 4; ++e) rli[4 * g + e] = __builtin_amdgcn_rcpf(lv[e]); }
    LAS unsigned short* stg = (LAS unsigned short*)(shm + LY::OST) + wid * 2048;
#pragma unroll
    for (int r = 0; r < 16; ++r) { const int orow = crow(r, hi);
#pragma unroll
        for (int d0 = 0; d0 < 2; ++d0) stg[orow * 64 + d0 * 32 + r32] = (unsigned short)f2bf(o[d0][r] * rli[r]); }
    asm volatile("s_waitcnt lgkmcnt(0)" ::: "memory");
    bf16* Ow = T.Y + ((size_t)b * SEQ + qb * 256 + wid * 32) * 1024 + T.ycol + h * 64;
#pragma unroll
    for (int i = 0; i < 4; ++i) { const int row = i * 8 + (lane >> 3), ch = lane & 7; const u32x4 v = *(LAS const u32x4*)(stg + row * 64 + ch * 8); *(u32x4*)(Ow + (size_t)row * 1024 + ch * 8) = v; }
    asm volatile("s_waitcnt lgkmcnt(0)\n\ts_barrier" ::: "memory");
}
}

struct EpiGate {
    static constexpr bool PERM = true;
    const bf16* SG; bf16* MG; int accumulate;
    __device__ __forceinline__ void operator()(const pg8::f32x4 (&acc)[2][2][4][2], const pg8::Unit& u, int wr, int wc, int fr, int fq) const {
#pragma unroll
        for (int ai = 0; ai < 2; ++ai)
#pragma unroll
            for (int m = 0; m < 4; ++m) {
                const int r = u.pm * 256 + ai * 128 + wr * 64 + m * 16 + fr;
#pragma unroll
                for (int bj = 0; bj < 2; ++bj) {
                    const size_t off = (size_t)r * 1024 + u.pn * 256 + bj * 128 + wc * 32 + 8 * fq;
                    const pg8::u32x4 sg = *(const pg8::u32x4*)(SG + off);
                    pg8::f32x4 v0 = acc[ai][bj][m][0], v1 = acc[ai][bj][m][1];
#pragma unroll
                    for (int e = 0; e < 2; ++e) { v0[2 * e] *= __builtin_bit_cast(float, sg[e] << 16); v0[2 * e + 1] *= __builtin_bit_cast(float, sg[e] & 0xffff0000u);
                                                  v1[2 * e] *= __builtin_bit_cast(float, sg[2 + e] << 16); v1[2 * e + 1] *= __builtin_bit_cast(float, sg[2 + e] & 0xffff0000u); }
                    if (accumulate) { const pg8::u32x4 pv = *(const pg8::u32x4*)(MG + off);
#pragma unroll
                        for (int e = 0; e < 2; ++e) { v0[2 * e] += __builtin_bit_cast(float, pv[e] << 16); v0[2 * e + 1] += __builtin_bit_cast(float, pv[e] & 0xffff0000u);
                                                      v1[2 * e] += __builtin_bit_cast(float, pv[2 + e] << 16); v1[2 * e + 1] += __builtin_bit_cast(float, pv[2 + e] & 0xffff0000u); } }
                    *(pg8::u32x4*)(MG + off) = pg8::pack8(v0, v1);
                }
            }
    }
};
struct EpiRes {
    static constexpr bool PERM = false;
    const float* X; float* H1;
    __device__ __forceinline__ void operator()(const pg8::f32x4 (&acc)[2][2][4][2], const pg8::Unit& u, int wr, int wc, int fr, int fq) const {
#pragma unroll
        for (int ai = 0; ai < 2; ++ai)
#pragma unroll
            for (int m = 0; m < 4; ++m) {
                const size_t ro = (size_t)(u.pm * 256 + ai * 128 + wr * 64 + m * 16 + fr) * 1024 + u.pn * 256 + wc * 32 + 4 * fq;
#pragma unroll
                for (int bj = 0; bj < 2; ++bj)
#pragma unroll
                    for (int n = 0; n < 2; ++n) { const size_t off = ro + bj * 128 + n * 16; *(pg8::f32x4*)(H1 + off) = *(const pg8::f32x4*)(X + off) + acc[ai][bj][m][n]; }
            }
    }
};

constexpr size_t RT_RIDX = WS_RT, RT_RW = WS_RT + 128 * 1024, RT_RANK = WS_RT + 256 * 1024, RT_CNT = WS_RT + 384 * 1024, RT_TOKSLOT = WS_RT + 512 * 1024,
                 RT_ROWIDX = WS_RT + 640 * 1024, RT_ROWW = WS_RT + 832 * 1024, RT_TILEE = WS_RT + 1024 * 1024, RT_NT = WS_RT + 1024 * 1024 + 4096;
constexpr int MAXSLOT = 40960;
constexpr int RTAB_BYTES = 147456, P6_SCR = RTAB_BYTES;
__device__ __forceinline__ float wred(float v) { return wave_sum(v); }
__device__ __forceinline__ void p6a_route(const Frame& F, const Ptrs& P) {
    unsigned char* ws = P.ws; const int lane = F.lane, tid = F.tid;
    LAS f32x4* RTg = (LAS f32x4*)(F.lds);
    LAS f32x4* RTe = (LAS f32x4*)(F.lds + 16384);
    LAS int* eid = (LAS int*)(F.lds + P6_SCR);
    const float* wgr = P.in[13]; const float* wer = P.in[15];
    for (int i = tid; i < 1024; i += NWAVES * 64) { const int l = i & 63, je = i >> 6, k = 4 * (l + 64 * (je >> 2)) + (je & 3); RTg[i] = *(const f32x4*)(wgr + (size_t)k * 4); }
    for (int i = tid; i < 8192; i += NWAVES * 64) { const int l = i & 63, half = (i >> 6) & 1, g = (i >> 7) & 3, je = i >> 9, k = 4 * (l + 64 * (je >> 2)) + (je & 3);
        RTe[i] = *(const f32x4*)(wer + (size_t)k * 32 + 8 * g + 4 * half); }
    f32x4 gn[4];
#pragma unroll
    for (int j = 0; j < 4; ++j) gn[j] = ((const f32x4*)P.in[12])[lane + 64 * j];
    float bg[4], be_[32];
#pragma unroll
    for (int c = 0; c < 4; ++c) bg[c] = P.in[14][c];
    LDS_WAIT(); __syncthreads();
    const float* H1 = P.out; bf16* T = (bf16*)(ws + WS_T);
    int* RIDX = (int*)(ws + RT_RIDX); float* RW = (float*)(ws + RT_RW); int* RANK = (int*)(ws + RT_RANK); int* CNT = (int*)(ws + RT_CNT);
    (void)be_;
    for (int v = F.vcu; v < 256; v += F.G) {
        for (int i = 0; i < 8; ++i) {
            const int tl = F.wave * 8 + i, tok = v * 64 + tl;
            const f32x4* hr = (const f32x4*)(H1 + (size_t)tok * DM) + lane;
            f32x4 hv[4]; float ss = 0.f;
#pragma unroll
            for (int j = 0; j < 4; ++j) { hv[j] = hr[64 * j]; ss += (hv[j].x * hv[j].x + hv[j].y * hv[j].y) + (hv[j].z * hv[j].z + hv[j].w * hv[j].w); }
            const float rstd = 1.f / sqrtf(wave_sum(ss) * (1.f / DM) + EPSN);
            unsigned long long* o8 = (unsigned long long*)(T + (size_t)tok * DM) + lane;
            f32x4 a4 = (f32x4){0.f, 0.f, 0.f, 0.f};
#pragma unroll
            for (int j = 0; j < 4; ++j) { hv[j] = hv[j] * rstd * gn[j]; o8[64 * j] = (unsigned long long)pk2(hv[j].x, hv[j].y) | ((unsigned long long)pk2(hv[j].z, hv[j].w) << 32);
#pragma unroll
                for (int e = 0; e < 4; ++e) a4 += RTg[(j * 4 + e) * 64 + lane] * hv[j][e]; }
            float gl[4];
#pragma unroll
            for (int c = 0; c < 4; ++c) gl[c] = wave_sum(a4[c]) + bg[c];
            int g = 0; float gm = gl[0];
#pragma unroll
            for (int c = 1; c < 4; ++c) if (gl[c] > gm) { gm = gl[c]; g = c; }
            float gs = 0.f;
#pragma unroll
            for (int c = 0; c < 4; ++c) gs += expf(gl[c] - gm);
            const float gw = 1.f / gs;
            f32x4 e0 = (f32x4){0.f, 0.f, 0.f, 0.f}, e1 = e0;
#pragma unroll
            for (int j = 0; j < 4; ++j)
#pragma unroll
                for (int e = 0; e < 4; ++e) { const int base = (((j * 4 + e) * 4 + g) * 2) * 64 + lane; e0 += RTe[base] * hv[j][e]; e1 += RTe[base + 64] * hv[j][e]; }
            float el[8];
#pragma unroll
            for (int c = 0; c < 4; ++c) { el[c] = wave_sum(e0[c]) + P.in[16][g * 8 + c]; el[4 + c] = wave_sum(e1[c]) + P.in[16][g * 8 + 4 + c]; }
            int i0 = 0; float v0 = el[0];
#pragma unroll
            for (int c = 1; c < 8; ++c) if (el[c] > v0) { v0 = el[c]; i0 = c; }
            int i1 = -1; float v1 = -INFINITY;
#pragma unroll
            for (int c = 0; c < 8; ++c) if (c != i0 && el[c] > v1) { v1 = el[c]; i1 = c; }
            const float p1 = expf(v1 - v0), w0 = gw / (1.f + p1), w1 = gw * p1 / (1.f + p1);
            if (lane == 0) { RIDX[tok * 2] = g * 8 + i0; RIDX[tok * 2 + 1] = g * 8 + i1; RW[tok * 2] = w0; RW[tok * 2 + 1] = w1; eid[tl * 2] = g * 8 + i0; eid[tl * 2 + 1] = g * 8 + i1; }
        }
        LDS_WAIT(); __syncthreads();
        if (tid < 32) { int c = 0; for (int j = 0; j < 128; ++j) c += (eid[j] == tid) ? 1 : 0; CNT[v * 32 + tid] = c; }
        if (tid >= 64 && tid < 192) { const int a = tid - 64, me = eid[a]; int r = 0; for (int j = 0; j < a; ++j) r += (eid[j] == me) ? 1 : 0; RANK[(v * 64) * 2 + a] = r; }
        __syncthreads();
    }
}
__device__ __forceinline__ void p6b_lists(const Frame& F, const Ptrs& P) {
    unsigned char* ws = P.ws; const int tid = F.tid;
    LAS int* sh = (LAS int*)(F.lds + P6_SCR);
    const int* RIDX = (const int*)(ws + RT_RIDX); const float* RW = (const float*)(ws + RT_RW); const int* RANK = (const int*)(ws + RT_RANK); const int* CNT = (const int*)(ws + RT_CNT);
    int* TOKSLOT = (int*)(ws + RT_TOKSLOT); int* ROWIDX = (int*)(ws + RT_ROWIDX); float* ROWW = (float*)(ws + RT_ROWW); int* TILEE = (int*)(ws + RT_TILEE); int* NT = (int*)(ws + RT_NT);
    for (int v = F.vcu; v < 256; v += F.G) {
        if (tid < 32) { int tot = 0, pre = 0; for (int j = 0; j < 256; ++j) { const int c = CNT[j * 32 + tid]; tot += c; pre += j < v ? c : 0; } sh[tid] = tot; sh[32 + tid] = pre; }
        LDS_WAIT(); __syncthreads();
        if (tid == 0) { int b = 0; for (int e = 0; e < 32; ++e) { sh[64 + e] = b; b += (sh[e] + 255) & ~255; } sh[96] = b; }
        LDS_WAIT(); __syncthreads();
        if (tid < 128) { const int a = tid, tok = v * 64 + (a >> 1), e = RIDX[(v * 64) * 2 + a]; const int slot = sh[64 + e] + sh[32 + e] + RANK[(v * 64) * 2 + a];
            ROWIDX[slot] = tok; ROWW[slot] = RW[(v * 64) * 2 + a]; TOKSLOT[(v * 64) * 2 + a] = slot; }
        if (v < 32) {
            const int e = v, b0 = sh[64 + e], tot = sh[e], pad = (tot + 255) & ~255;
            for (int s = tot + tid; s < pad; s += NWAVES * 64) { ROWIDX[b0 + s] = 0; ROWW[b0 + s] = 0.f; }
            for (int t = tid; t < pad / 256; t += NWAVES * 64) TILEE[b0 / 256 + t] = e;
            if (e == 0 && tid == 0) NT[0] = sh[96] / 256;
        }
        __syncthreads();
    }
}
struct MoeOrder {
    const int* tilee; int ntiles, nc, G, c;
    __device__ __forceinline__ bool next(int i, pg8::Unit& u) const {
        const int L = i * G + c; if (L >= ntiles * nc) return false;
        u.pm = L / nc; u.pn = L % nc; u.be = tilee[u.pm]; return true; }
};
struct EpiUp {
    static constexpr bool PERM = true;
    const float* ROWW; bf16* HM;
    __device__ __forceinline__ void operator()(const pg8::f32x4 (&acc)[2][2][4][2], const pg8::Unit& u, int wr, int wc, int fr, int fq) const {
#pragma unroll
        for (int ai = 0; ai < 2; ++ai)
#pragma unroll
            for (int m = 0; m < 4; ++m) {
                const int r = u.pm * 256 + ai * 128 + wr * 64 + m * 16 + fr; const float cw = ROWW[r];
                pg8::f32x4 o[2];
#pragma unroll
                for (int n = 0; n < 2; ++n)
#pragma unroll
                    for (int e = 0; e < 4; ++e) { const float a = acc[ai][0][m][n][e], b = acc[ai][1][m][n][e]; o[n][e] = a * sigmoid_fast(a) * b * cw; }
                *(pg8::u32x4*)(HM + (size_t)r * FE + u.pn * 128 + wc * 32 + 8 * fq) = pg8::pack8(o[0], o[1]);
            }
    }
};
struct EpiDown {
    static constexpr bool PERM = true;
    bf16* YE;
    __device__ __forceinline__ void operator()(const pg8::f32x4 (&acc)[2][2][4][2], const pg8::Unit& u, int wr, int wc, int fr, int fq) const {
#pragma unroll
        for (int ai = 0; ai < 2; ++ai)
#pragma unroll
            for (int m = 0; m < 4; ++m) {
                const size_t ro = (size_t)(u.pm * 256 + ai * 128 + wr * 64 + m * 16 + fr) * 1024 + u.pn * 256 + wc * 32 + 8 * fq;
#pragma unroll
                for (int bj = 0; bj < 2; ++bj) *(pg8::u32x4*)(YE + ro + bj * 128) = pg8::pack8(acc[ai][bj][m][0], acc[ai][bj][m][1]);
            }
    }
};
__device__ __forceinline__ void p9_final(const Frame& F, const Ptrs& P) {
    unsigned char* ws = P.ws; const int lane = F.lane; const int gw = F.vcu * NWAVES + F.wave, NGW = F.G * NWAVES;
    const int* TOKSLOT = (const int*)(ws + RT_TOKSLOT); const bf16* YE = (const bf16*)(ws + WS_YE);
    f32x4 gn[4];
#pragma unroll
    for (int j = 0; j < 4; ++j) gn[j] = ((const f32x4*)P.in[20])[lane + 64 * j];
    for (int tok = gw; tok < TR; tok += NGW) {
        const int s0 = TOKSLOT[tok * 2], s1 = TOKSLOT[tok * 2 + 1];
        f32x4* hr = (f32x4*)(P.out + (size_t)tok * DM) + lane;
        const unsigned long long* y0 = (const unsigned long long*)(YE + (size_t)s0 * DM) + lane; const unsigned long long* y1 = (const unsigned long long*)(YE + (size_t)s1 * DM) + lane;
        f32x4 v[4]; float ss = 0.f;
#pragma unroll
        for (int j = 0; j < 4; ++j) { v[j] = hr[64 * j]; const unsigned long long a = y0[64 * j], b = y1[64 * j];
            v[j].x += bf2f((unsigned short)a) + bf2f((unsigned short)b); v[j].y += bf2f((unsigned short)(a >> 16)) + bf2f((unsigned short)(b >> 16));
            v[j].z += bf2f((unsigned short)(a >> 32)) + bf2f((unsigned short)(b >> 32)); v[j].w += bf2f((unsigned short)(a >> 48)) + bf2f((unsigned short)(b >> 48));
            ss += (v[j].x * v[j].x + v[j].y * v[j].y) + (v[j].z * v[j].z + v[j].w * v[j].w); }
        const float rstd = 1.f / sqrtf(wave_sum(ss) * (1.f / DM) + EPSN);
#pragma unroll
        for (int j = 0; j < 4; ++j) hr[64 * j] = v[j] * rstd * gn[j];
    }
}

#ifndef REP_PHASE
#define REP_PHASE (-1)
#endif
#ifndef REP_ATT
#define REP_ATT 3
#endif
__global__ void __launch_bounds__(NWAVES * 64, 2) mega(Ptrs P) {
    extern __shared__ __attribute__((aligned(16))) unsigned char lds_raw[];
    Frame F;
    F.lds = (LAS unsigned char*)lds_raw;
    F.MISC = (volatile LAS unsigned*)(F.lds + MISC_OFF);
    F.tid = threadIdx.x; F.lane = F.tid & 63; F.wave = __builtin_amdgcn_readfirstlane(F.tid >> 6);
    F.G = gridDim.x; { const int bx = blockIdx.x; F.vcu = (F.G % 8 == 0) ? (bx % 8) * (F.G / 8) + bx / 8 : bx; }
    unsigned char* ws = P.ws;
    F.ctl = (unsigned*)(ws + WS_CTL);
    for (int u = F.tid; u < (LDS_BYTES - LDSCTL_OFF) / 4; u += NWAVES * 64) ((LAS unsigned*)(F.lds + LDSCTL_OFF))[u] = 0u;
    __syncthreads();
    const int lo = P.ph_lo, hi = P.ph_hi;
    XcdBarrier bar; bar.bar = F.ctl + CW_BAR; bar.x = 0; bar.st = nullptr;
    if (hi - lo > 1) bar = xcd_barrier_post(F.ctl + CW_BAR, F.MISC + 8);
#define IN(k) (lo <= (k) && (k) < hi)
#define SEAM(k) do { if (IN(k) && IN((k) + 1)) xcd_barrier(bar); } while (0)
#define RUN(k, BODY) do { if (IN(k)) { BODY; if (REP_PHASE == (k)) { xcd_barrier(bar); BODY; } } SEAM(k); } while (0)

#define PH0 do { p0_prologue(F, P); } while (0)
#define PH1 do { pg8::Gemm g{(const bf16*)(ws + WS_U), (const bf16*)(ws + WS_WIN), DM, DM, nullptr, 0}; \
        DenseOrder S; S.init(MROWS / 256, NIN / 256, F.G, (int)blockIdx.x); EpiP1 E{ws, (bf16*)P.out}; \
        pg8::gemm_phase<EpiP1, DenseOrder, true>(F.lds + RING_OFF, g, S, E); } while (0)
#define PH2 do { \
        { pg8::Gemm g{(const bf16*)(ws + WS_CQ), (const bf16*)(ws + WS_WQUP), 512, 512, nullptr, 0}; DenseOrder S; S.init(TR / 256, 3, F.G, (int)blockIdx.x); \
          EpiQ E{ws}; pg8::gemm_phase<EpiQ, DenseOrder, true>(F.lds + RING_OFF, g, S, E); } \
        { pg8::Gemm g{(const bf16*)(ws + WS_CKV), (const bf16*)(ws + WS_WKVUP), 256, 256, nullptr, 0}; DenseOrder S; S.init(MROWS / 256, 4, F.G, (int)blockIdx.x); \
          EpiKV E{ws}; pg8::gemm_phase<EpiKV, DenseOrder, true>(F.lds + RING_OFF, g, S, E); } \
        p2_small(F, P); } while (0)
#define PH3X(DOM, DOF) do { \
        const att::Tens TM{(const bf16*)(ws + WS_QM), 768, (const bf16*)(ws + WS_KM), 768, (const bf16*)(ws + WS_VM), (const float*)(ws + WS_BIAS0), (bf16*)(ws + WS_Y), 0, nullptr}; \
        const att::Tens TF{(const bf16*)(ws + WS_FQ), 512, (const bf16*)(ws + WS_FK), 512, (const bf16*)(ws + WS_FV), (const float*)(ws + WS_CB), (bf16*)(ws + WS_Y), 512, (const float*)(ws + WS_KNMAX)}; \
        LAS char* shm = (LAS char*)(F.lds + RING_OFF); \
        for (int v = F.vcu; v < 256; v += F.G) { \
            const int bh = v >> 4, s = v & 15, b = bh >> 3, h = bh & 7; \
            if (DOM) att::mla_unit<8>(b, h, 31 - s, TM, shm); \
            if (DOF) att::attn_unit<64, true, 8>(b, h, 31 - s, TF, shm); \
            if (DOM) att::mla_unit<8>(b, h, s, TM, shm); \
            if (DOF) att::attn_unit<64, true, 8>(b, h, s, TF, shm); \
        } } while (0)
#define PH4 do { DenseOrder S; S.init(TR / 256, 4, F.G, (int)blockIdx.x); \
        { pg8::Gemm g{(const bf16*)(ws + WS_Y), (const bf16*)(ws + WS_WA), 512, 1024, nullptr, 0}; \
          EpiGate E{(const bf16*)P.out, (bf16*)(ws + WS_MERGED), 0}; pg8::gemm_phase<EpiGate, DenseOrder, true>(F.lds + RING_OFF, g, S, E); } \
        { pg8::Gemm g{(const bf16*)(ws + WS_Y) + 512, (const bf16*)(ws + WS_WB), 512, 1024, nullptr, 0}; \
          EpiGate E{(const bf16*)P.out + (size_t)TR * 1024, (bf16*)(ws + WS_MERGED), 1}; pg8::gemm_phase<EpiGate, DenseOrder, true>(F.lds + RING_OFF, g, S, E); } } while (0)
#define PH5 do { DenseOrder S; S.init(TR / 256, 4, F.G, (int)blockIdx.x); \
        pg8::Gemm g{(const bf16*)(ws + WS_MERGED), (const bf16*)(ws + WS_WOUT), 1024, 1024, nullptr, 0}; \
        EpiRes E{P.in[0], P.out}; pg8::gemm_phase<EpiRes, DenseOrder, true>(F.lds + RING_OFF, g, S, E); } while (0)
#define PH6 do { p6a_route(F, P); } while (0)
#define PH7 do { p6b_lists(F, P); } while (0)
#define PH8 do { MoeOrder S{(const int*)(ws + RT_TILEE), *(const int*)(ws + RT_NT), 2, F.G, F.vcu}; \
        pg8::Gemm g{(const bf16*)(ws + WS_T), (const bf16*)(ws + WS_WUP), 1024, 1024, (const int*)(ws + RT_ROWIDX), (size_t)512 * 1024 * 2}; \
        EpiUp E{(const float*)(ws + RT_ROWW), (bf16*)(ws + WS_HM)}; pg8::gemm_phase<EpiUp, MoeOrder, true>(F.lds + RING_OFF, g, S, E); } while (0)
#define PH9 do { MoeOrder S{(const int*)(ws + RT_TILEE), *(const int*)(ws + RT_NT), 4, F.G, F.vcu}; \
        pg8::Gemm g{(const bf16*)(ws + WS_HM), (const bf16*)(ws + WS_WD), 256, 256, nullptr, (size_t)1024 * 256 * 2}; \
        EpiDown E{(bf16*)(ws + WS_YE)}; pg8::gemm_phase<EpiDown, MoeOrder, true>(F.lds + RING_OFF, g, S, E); } while (0)

    RUN(0, PH0);
    if (IN(1)) { PH1; if (REP_PHASE == 1) { xcd_barrier(bar); for (int i = F.vcu * 512 + F.tid; i < MROWS; i += F.G * 512) { ((float*)(ws + WS_SSQQ))[i] = 0.f; ((float*)(ws + WS_SSQKV))[i] = 0.f; } xcd_barrier(bar); PH1; } } SEAM(1);
    RUN(2, PH2);
    if (IN(3)) { PH3X(true, true); if (REP_PHASE == 3) { xcd_barrier(bar); PH3X((REP_ATT & 1) != 0, (REP_ATT & 2) != 0); } } SEAM(3);
    RUN(4, PH4);
    RUN(5, PH5);
    RUN(6, PH6);
    RUN(7, PH7);
    RUN(8, PH8);
    RUN(9, PH9);
    if (IN(10)) { p9_final(F, P); }
#undef IN
#undef SEAM
#undef RUN
}

extern "C" void kernel_launch(void* const* d_in, const int* in_sizes, int n_in, void* d_out, int out_size, void* d_ws, size_t ws_size, hipStream_t stream) {
    static int grid = 0;
    if (grid == 0) {
        if (n_in != 21 || out_size != TR * DM || ws_size < WS_END) { fprintf(stderr, "kernel_launch: unexpected shapes (n_in %d, out %d, ws %zu)\n", n_in, out_size, ws_size); grid = -1; return; }
        int dev = 0, cus = 0;
        if (hipGetDevice(&dev) != hipSuccess || hipDeviceGetAttribute(&cus, hipDeviceAttributeMultiprocessorCount, dev) != hipSuccess) { grid = -1; return; }
        if (hipFuncSetAttribute((const void*)mega, hipFuncAttributeMaxDynamicSharedMemorySize, LDS_BYTES) != hipSuccess) { fprintf(stderr, "kernel_launch: hipFuncSetAttribute failed\n"); grid = -1; return; }
        int per_cu = 0; (void)hipOccupancyMaxActiveBlocksPerMultiprocessor(&per_cu, (const void*)mega, NWAVES * 64, LDS_BYTES); (void)hipGetLastError();
        grid = cus;
    }
    if (grid < 0) return;
    (void)hipMemsetAsync((char*)d_ws + WS_CTL, 0, CTL_ZERO_BYTES, stream);
    Ptrs p{};
    for (int i = 0; i < 21; ++i) p.in[i] = (const float*)d_in[i];
    p.out = (float*)d_out; p.ws = (unsigned char*)d_ws;
    p.ph_lo = 0; p.ph_hi = 11;
    hipLaunchKernelGGL(mega, dim3(grid), dim3(NWAVES * 64), LDS_BYTES, stream, p);

}
```

```cpp
#include <hip/hip_runtime.h>
#include <cstdio>
#include <cstdint>
#include <cmath>

namespace pg8 {
#define PG8_LAS __attribute__((address_space(3)))
typedef unsigned short bf16_t;
typedef short bf16x8 __attribute__((ext_vector_type(8)));
typedef float f32x4 __attribute__((ext_vector_type(4)));
typedef unsigned u32x4 __attribute__((ext_vector_type(4)));
constexpr int BM = 256, BK = 64, HALF = 128, HTB = HALF * BK * 2  , STAGE_BYTES = 8 * HTB;

__host__ __device__ __forceinline__ int lds_byte(int r, int c) { const int st = (r >> 4) * 2 + (c >> 5), rr = r & 15, cc = c & 31, ob = rr * 64 + cc * 2; return st * 1024 + (ob ^ (((ob >> 9) & 1) << 5)); }
__host__ __device__ __forceinline__ void stage_rc(int b, int& R, int& C) { const int st = b / 1024, sb = b % 1024, swz = sb ^ (((sb >> 9) & 1) << 5); R = (st >> 1) * 16 + swz / 64; C = (st & 1) * 32 + (swz % 64) / 2; }
__host__ __device__ __forceinline__ int perm32(int rho) { const int n = rho >> 4, i = rho & 15; return 8 * (i >> 2) + 4 * n + (i & 3); }

struct Unit { int pm, pn, be, rbase, rcnt; };
struct Gemm { const bf16_t* A; const bf16_t* Bt; int K, lda; const int* rowidx; size_t bstride; };

__device__ __forceinline__ unsigned cvt_pk_bf16(float lo, float hi) { unsigned r; asm volatile("v_cvt_pk_bf16_f32 %0, %1, %2" : "=v"(r) : "v"(lo), "v"(hi)); return r; }
__device__ __forceinline__ u32x4 pack8(const f32x4 v0, const f32x4 v1) { u32x4 w; w.x = cvt_pk_bf16(v0[0], v0[1]); w.y = cvt_pk_bf16(v0[2], v0[3]); w.z = cvt_pk_bf16(v1[0], v1[1]); w.w = cvt_pk_bf16(v1[2], v1[3]); return w; }

template <class Epi, class Sched, bool ALIGN_EPI, bool MIDHOOK = false>
__device__ __forceinline__ void gemm_phase(PG8_LAS unsigned char* lds, const Gemm g, const Sched& S, const Epi& E) {
    const int tid = threadIdx.x, wid = __builtin_amdgcn_readfirstlane(tid >> 6), lane = tid & 63, wr = wid >> 2, wc = wid & 3, fr = lane & 15, fq = lane >> 4;
    const int K = g.K, nt = K / BK;
    int sR[2], sC[2]; unsigned voffB[2];
#pragma unroll
    for (int i = 0; i < 2; ++i) { int R, C; stage_rc(tid * 16 + i * 8192, R, C); const int Rb = Epi::PERM ? ((R & ~31) + perm32(R & 31)) : R;
        sR[i] = R; sC[i] = C; voffB[i] = (unsigned)(Rb * K + C) * 2u; }
    const size_t kstep = (size_t)(BK * 2);
    const size_t hstepB = (size_t)HALF * K * 2;
    const size_t tstepB = 2 * hstepB;
    const unsigned ldsw = (unsigned)wid * 1024u;
    const int aoff = lds_byte(wr * 64 + fr, fq * 8), boff = lds_byte(wc * 32 + fr, fq * 8);
#define PG8_MKV(v, u) do { _Pragma("unroll") for (int _h = 0; _h < 2; ++_h) _Pragma("unroll") for (int _i = 0; _i < 2; ++_i) { \
        const int _lr = _h * HALF + sR[_i]; const int _row = g.rowidx ? (_lr < (u).rcnt ? g.rowidx[(u).rbase + _lr] : 0) : (u).pm * BM + _lr; (v)[_h][_i] = ((unsigned)_row * (unsigned)g.lda + (unsigned)sC[_i]) * 2u; } } while (0)
#define PG8_SA(b, h) (((b) * 2 + (h)) * HTB)
#define PG8_SB(b, h) ((4 + (b) * 2 + (h)) * HTB)
#define PG8_STAGE(bufoff, gbase, voff) do { _Pragma("unroll") for (int _i = 0; _i < 2; ++_i) \
        __builtin_amdgcn_global_load_lds((const unsigned*)((const char*)(gbase) + (voff)[_i]), (PG8_LAS unsigned*)(lds + (bufoff) + ldsw + _i * 8192), 16, 0, 0); } while (0)
#define PG8_LDA(dst, b, h) do { _Pragma("unroll") for (int m = 0; m < 4; ++m) _Pragma("unroll") for (int k = 0; k < 2; ++k) dst[m][k] = *(const PG8_LAS bf16x8*)(lds + PG8_SA(b, h) + aoff + m * 2048 + k * 1024); } while (0)
#define PG8_LDB(dst, b, h) do { _Pragma("unroll") for (int n = 0; n < 2; ++n) _Pragma("unroll") for (int k = 0; k < 2; ++k) dst[n][k] = *(const PG8_LAS bf16x8*)(lds + PG8_SB(b, h) + boff + n * 2048 + k * 1024); } while (0)
#define PG8_MMA(ai, bj, At, Bt) do { __builtin_amdgcn_s_setprio(1); _Pragma("unroll") for (int m = 0; m < 4; ++m) _Pragma("unroll") for (int n = 0; n < 2; ++n) _Pragma("unroll") for (int k = 0; k < 2; ++k) \
        acc[ai][bj][m][n] = __builtin_amdgcn_mfma_f32_16x16x32_bf16(Bt[n][k], At[m][k], acc[ai][bj][m][n], 0, 0, 0); __builtin_amdgcn_s_setprio(0); } while (0)
#define PG8_WAIT_V(n) asm volatile("s_waitcnt vmcnt(" #n ")" ::: "memory")
#define PG8_WAIT_L(n) asm volatile("s_waitcnt lgkmcnt(" #n ")" ::: "memory")
#define PG8_BAR __builtin_amdgcn_s_barrier()
#define PG8_SCHED __builtin_amdgcn_sched_barrier(0)
    Unit cur, nxt; int ui = 0;
    if (!S.next(0, cur)) return;
    f32x4 acc[2][2][4][2];
#pragma unroll
    for (int a = 0; a < 2; ++a)
#pragma unroll
        for (int b = 0; b < 2; ++b)
#pragma unroll
            for (int m = 0; m < 4; ++m)
#pragma unroll
                for (int n = 0; n < 2; ++n) acc[a][b][m][n] = (f32x4){0.f, 0.f, 0.f, 0.f};
    bf16x8 At[4][2], B0[2][2], B1[2][2];
    unsigned vA[2][2], vN[2][2];
    PG8_MKV(vA, cur);
    const char* const pA = (const char*)g.A;
    const char* cB = (const char*)g.Bt + (size_t)cur.be * g.bstride + (size_t)cur.pn * tstepB;
    PG8_STAGE(PG8_SB(0, 0), cB, voffB); PG8_STAGE(PG8_SB(0, 1), cB + hstepB, voffB); PG8_STAGE(PG8_SA(0, 0), pA, vA[0]); PG8_STAGE(PG8_SA(0, 1), pA, vA[1]);
    if (wr == 1) PG8_BAR;
    PG8_WAIT_V(2); PG8_BAR;
    PG8_STAGE(PG8_SB(1, 0), cB + kstep, voffB); PG8_STAGE(PG8_SA(1, 0), pA + kstep, vA[0]); PG8_STAGE(PG8_SB(1, 1), cB + hstepB + kstep, voffB);
    PG8_WAIT_V(6); PG8_BAR;
    for (;;) {
        const bool has_next = S.next(ui + 1, nxt);
        if (has_next) PG8_MKV(vN, nxt);
        else {
#pragma unroll
            for (int h = 0; h < 2; ++h)
#pragma unroll
                for (int i = 0; i < 2; ++i) vN[h][i] = vA[h][i];
        }
        const char* nB = has_next ? (const char*)g.Bt + (size_t)nxt.be * g.bstride + (size_t)nxt.pn * tstepB : cB;
        for (int t = 0; t < nt; t += 2) {
            const bool last = (t == nt - 2);
            if constexpr (MIDHOOK) { if (t == nt / 2) E.mid(acc, cur, wr, wc, fr, fq); }
            const char* a1 = pA + (size_t)(t + 1) * kstep;
            const char* a2 = last ? pA : pA + (size_t)(t + 2) * kstep; const char* b2 = last ? nB : cB + (size_t)(t + 2) * kstep;
            const char* a3 = a2 + kstep; const char* b3 = b2 + kstep;
            unsigned w0[2], w1[2];
#pragma unroll
            for (int i = 0; i < 2; ++i) { w0[i] = last ? vN[0][i] : vA[0][i]; w1[i] = last ? vN[1][i] : vA[1][i]; }
            PG8_LDB(B0, 0, 0); PG8_LDB(B1, 0, 1); PG8_SCHED; PG8_LDA(At, 0, 0); PG8_STAGE(PG8_SA(1, 1), a1, vA[1]);
            PG8_WAIT_V(8); PG8_WAIT_L(0); PG8_BAR; PG8_MMA(0, 0, At, B0); PG8_MMA(0, 1, At, B1); PG8_BAR; PG8_SCHED;
            PG8_LDA(At, 0, 1); PG8_STAGE(PG8_SB(0, 0), b2, voffB); PG8_STAGE(PG8_SB(0, 1), b2 + hstepB, voffB); PG8_STAGE(PG8_SA(0, 0), a2, w0);
            PG8_WAIT_V(8); PG8_WAIT_L(0); PG8_BAR; PG8_MMA(1, 0, At, B0); PG8_MMA(1, 1, At, B1); PG8_BAR; PG8_SCHED;
            PG8_LDB(B0, 1, 0); PG8_LDB(B1, 1, 1); PG8_SCHED; PG8_LDA(At, 1, 0); PG8_STAGE(PG8_SA(0, 1), a2, w1);
            PG8_WAIT_V(8); PG8_WAIT_L(0); PG8_BAR; PG8_MMA(0, 0, At, B0); PG8_MMA(0, 1, At, B1); PG8_BAR; PG8_SCHED;
            PG8_LDA(At, 1, 1); PG8_STAGE(PG8_SB(1, 0), b3, voffB); PG8_STAGE(PG8_SB(1, 1), b3 + hstepB, voffB); PG8_STAGE(PG8_SA(1, 0), a3, w0);
            PG8_WAIT_V(8); PG8_WAIT_L(0); PG8_BAR; PG8_MMA(1, 0, At, B0); PG8_MMA(1, 1, At, B1); PG8_BAR; PG8_SCHED;
        }
        if constexpr (ALIGN_EPI) { if (wr == 0) PG8_BAR; }
        E(acc, cur, wr, wc, fr, fq);
        if (!has_next) break;
#pragma unroll
        for (int a = 0; a < 2; ++a)
#pragma unroll
            for (int b = 0; b < 2; ++b)
#pragma unroll
                for (int m = 0; m < 4; ++m)
#pragma unroll
                    for (int n = 0; n < 2; ++n) acc[a][b][m][n] = (f32x4){0.f, 0.f, 0.f, 0.f};
        cur = nxt; cB = nB; ++ui;
#pragma unroll
        for (int h = 0; h < 2; ++h)
#pragma unroll
            for (int i = 0; i < 2; ++i) vA[h][i] = vN[h][i];
        if constexpr (ALIGN_EPI) { if (wr == 1) PG8_BAR; }
    }
    PG8_WAIT_V(0);
    if constexpr (!ALIGN_EPI) { if (wr == 0) PG8_BAR; }
    PG8_BAR;
#undef PG8_MKV
#undef PG8_SA
#undef PG8_SB
#undef PG8_STAGE
#undef PG8_LDA
#undef PG8_LDB
#undef PG8_MMA
#undef PG8_WAIT_V
#undef PG8_WAIT_L
#undef PG8_BAR
#undef PG8_SCHED
}
}

#define GAS __attribute__((address_space(1)))
#define LAS __attribute__((address_space(3)))
#define XB_TMO      128
#define XB_XCNT(j)  (256  + 64 * (j))
#define XB_XSUB(j)  (1280 + 64 * (j))
#define XB_XGEN(j)  (2304 + 64 * (j))
#define XB_TOP      3328
#define XB_TOPGEN   3392
#define XCD_BAR_WORDS 3456
#define XB_SPIN_CAP (1u << 18)

__device__ __forceinline__ unsigned xb_ld(unsigned* p)              { return __hip_atomic_load(p, __ATOMIC_RELAXED, __HIP_MEMORY_SCOPE_AGENT); }
__device__ __forceinline__ unsigned xb_add(unsigned* p, unsigned v) { return __hip_atomic_fetch_add(p, v, __ATOMIC_RELAXED, __HIP_MEMORY_SCOPE_AGENT); }
__device__ __forceinline__ unsigned xb_xcc_id() { return (unsigned)__builtin_amdgcn_s_getreg((3 << 11) | 20) & 0xFu; }
#define XB_SPIN(cond, bar) do { unsigned _sp = 0; while (cond) { __builtin_amdgcn_s_sleep(1); \
    if ((++_sp & 255u) == 0u) { if (xb_ld(&(bar)[XB_TMO])) break; if (_sp > XB_SPIN_CAP) { atomicAdd(&(bar)[XB_TMO], 1u); break; } } } } while (0)

struct XcdBarrier { unsigned* bar; unsigned x; volatile LAS unsigned* st; };

__device__ __forceinline__ XcdBarrier xcd_barrier_post(unsigned* bar, volatile LAS unsigned* st) {
    XcdBarrier b; b.bar = bar; b.x = xb_xcc_id(); b.st = st;
    if (threadIdx.x == 0) (void)xb_add(&bar[XB_XCNT(b.x)], 1u);
    return b;
}
__device__ __forceinline__ void xcd_barrier_complete(unsigned* bar, unsigned x, unsigned& nloc, unsigned& nx) {
    const unsigned G = gridDim.x * gridDim.y * gridDim.z;
    unsigned sum, cnt, mine, sp = 0u;
    for (;;) {
        sum = 0u; cnt = 0u; mine = 0u;
#pragma unroll
        for (unsigned j = 0; j < 16; ++j) { const unsigned c = xb_ld(&bar[XB_XCNT(j)]); sum += c; cnt += (c > 0u) ? 1u : 0u; mine = (j == x) ? c : mine; }
        if (sum == G) break;
        __builtin_amdgcn_s_sleep(1);
        if ((++sp & 255u) == 0u) { if (xb_ld(&bar[XB_TMO])) break; if (sp > XB_SPIN_CAP) { atomicAdd(&bar[XB_TMO], 1u); break; } }
    }
    nloc = mine > 0u ? mine : 1u; nx = cnt > 0u ? cnt : 1u;
}
__device__ __forceinline__ void xcd_barrier(const XcdBarrier& b) {
    asm volatile("s_waitcnt vmcnt(0)" ::: "memory");
    __syncthreads();
    if (threadIdx.x == 0) {
        unsigned* bar = b.bar;
        __builtin_amdgcn_s_waitcnt(0);
        unsigned nloc = b.st[0], nx = b.st[1];
        if (nloc == 0u) { xcd_barrier_complete(bar, b.x, nloc, nx); b.st[0] = nloc; b.st[1] = nx; }
        const unsigned old = xb_add(&bar[XB_XSUB(b.x)], 1u);
        const unsigned gen = old / nloc;
        if (old + 1u == (gen + 1u) * nloc) {
            __builtin_amdgcn_fence(__ATOMIC_RELEASE, "agent");
            asm volatile("s_waitcnt vmcnt(0)" ::: "memory");
            const unsigned og = xb_add(&bar[XB_TOP], 1u);
            const unsigned tg = og / nx;
            if (og + 1u == (tg + 1u) * nx) xb_add(&bar[XB_TOPGEN], 1u);
            else XB_SPIN(xb_ld(&bar[XB_TOPGEN]) == tg, bar);
            __builtin_amdgcn_fence(__ATOMIC_ACQUIRE, "agent");
            xb_add(&bar[XB_XGEN(b.x)], 1u);
            asm volatile("s_waitcnt vmcnt(0)" ::: "memory");
        } else {
            XB_SPIN(xb_ld(&bar[XB_XGEN(b.x)]) == gen, bar);
            __builtin_amdgcn_fence(__ATOMIC_ACQUIRE, "agent");
            asm volatile("s_waitcnt vmcnt(0)" ::: "memory");
        }
    }
    __syncthreads();
}

constexpr int NWAVES = 8;
constexpr int NB = 2, SEQ = 8192, DM = 1024, NMETA = 16, LSEQ = SEQ + NMETA;
constexpr int TR = NB * SEQ;
constexpr int MROWS = TR + 256;
constexpr int LP = 64 + SEQ;
constexpr int ARROWS = NB * LP;
constexpr int DIN = 4392, NIN = 4608;
constexpr int NEXP = 32, FE = 256;
constexpr float EPSN = 1e-6f;
constexpr float LOG2E = 1.4426950408889634f;
constexpr float QS_MLA = 0.10206207261596575f * LOG2E;
constexpr float QS_FOX = 0.125f * LOG2E;
constexpr float BIG = 1e30f;

constexpr size_t MiB = 1u << 20;
constexpr size_t WS_CTL = 0, CTL_ZERO_BYTES = 1 * MiB;
constexpr size_t WS_SSQQ = 1 * MiB, WS_SSQKV = 1 * MiB + 512 * 1024;
constexpr size_t WS_COS = 2 * MiB, WS_SIN = 3 * MiB, WS_FL = 4 * MiB, WS_CB = 5 * MiB, WS_BIAS0 = 5 * MiB + 768 * 1024, WS_KNMAX = 5 * MiB + 896 * 1024, WS_RTAB = 11 * MiB, WS_KR = 6 * MiB, WS_RT = 9 * MiB;
constexpr size_t WS_WIN = 12 * MiB, WS_WQUP = 21 * MiB, WS_WKVUP = 22 * MiB, WS_WA = 23 * MiB, WS_WB = 24 * MiB, WS_WOUT = 25 * MiB, WS_WUP = 27 * MiB, WS_WD = 59 * MiB;
constexpr size_t WS_U = 75 * MiB, WS_CQ = 108 * MiB, WS_CKV = 125 * MiB, WS_FQ = 134 * MiB, WS_FK = 151 * MiB, WS_FV = 168 * MiB, WS_QM = 185 * MiB, WS_KM = 210 * MiB, WS_VM = 235 * MiB, WS_END = 252 * MiB;
constexpr size_t WS_Y = WS_U, WS_MERGED = 134 * MiB, WS_T = 166 * MiB, WS_HM = 108 * MiB, WS_YE = 128 * MiB;
static_assert(WS_U + (size_t)MROWS * DM * 2 <= WS_CQ && WS_CQ + (size_t)MROWS * 512 * 2 <= WS_CKV && WS_CKV + (size_t)MROWS * 256 * 2 <= WS_FQ, "ws map 1");
static_assert(WS_FQ + (size_t)ARROWS * 512 * 2 <= WS_FK && WS_FV + (size_t)ARROWS * 512 * 2 <= WS_QM && WS_QM + (size_t)ARROWS * 768 * 2 <= WS_KM && WS_KM + (size_t)ARROWS * 768 * 2 <= WS_VM && WS_VM + (size_t)ARROWS * 512 * 2 <= WS_END, "ws map 2");
static_assert(WS_WIN + (size_t)NIN * DM * 2 <= WS_WQUP && WS_WUP + (size_t)NEXP * 512 * 1024 * 2 <= WS_WD && WS_WD + (size_t)NEXP * 1024 * 256 * 2 <= WS_U, "ws map 3");
constexpr int CW_BAR = 4096;

constexpr int RING_OFF = 0, RING_BYTES = 131072, LDS_BYTES = 163840, LDSCTL_OFF = LDS_BYTES - 1024, MISC_OFF = LDSCTL_OFF + 320;

typedef unsigned short bf16;
typedef unsigned v4u __attribute__((ext_vector_type(4)));
typedef float f32x4 __attribute__((ext_vector_type(4)));
#define LDS_WAIT() asm volatile("s_waitcnt lgkmcnt(0)" ::: "memory")
#define VM_WAIT() asm volatile("s_waitcnt vmcnt(0)" ::: "memory")
__device__ __forceinline__ unsigned f2bf(float f) { unsigned u = __builtin_bit_cast(unsigned, f); return (u + 0x7fffu + ((u >> 16) & 1u)) >> 16; }
__device__ __forceinline__ unsigned pk2(float lo, float hi) { return f2bf(lo) | (f2bf(hi) << 16); }
__device__ __forceinline__ float bf2f(unsigned short v) { return __builtin_bit_cast(float, (unsigned)v << 16); }
__device__ __forceinline__ float wave_sum(float v) {
#pragma unroll
    for (int o = 1; o < 64; o <<= 1) v += __shfl_xor(v, o);
    return v;
}

struct Ptrs {
    const float* in[21]; float* out; unsigned char* ws; int ph_lo, ph_hi;
};
struct Frame {
    LAS unsigned char* lds; volatile LAS unsigned* MISC; unsigned* ctl;
    int tid, lane, wave, vcu, G;
};

__device__ __forceinline__ int srccol_in(int n) {
    if (n < 768) return n;
    if (n < 2304) return n + 32;
    if (n < 4352) return n + 40;
    if (n < 4384) { const int j = n - 4352, i = j >> 1; return 768 + ((j & 1) ? 16 + i : i); }
    if (n < 4392) return 2336 + (n - 4384);
    return -1;
}
__device__ __forceinline__ int srccol_q(int n) { const int h = n / 96, d = n % 96; if (d < 64) return n; const int j = d - 64, i = j >> 1; return h * 96 + 64 + ((j & 1) ? 16 + i : i); }

constexpr int NTILE = LP / 64;
template <int NCH> __device__ __forceinline__ size_t kimg_off(int bh, int ap, int chunk) { return ((size_t)(bh * NTILE + (ap >> 6)) * NCH + chunk) * 512 + (ap & 63) * 8; }
__device__ __forceinline__ size_t vimg_off(int bh, int ap, int d) { return ((size_t)(bh * NTILE + (ap >> 6)) * 2 + (d >> 5)) * 2048 + (ap & 63) * 32 + (d & 31); }
template <class Src>
__device__ __forceinline__ void transpose_item(const Src& src, int K, bf16* WT, LAS float* scr, int k0, int n0, int lane) {
    float tv[32];
#pragma unroll
    for (int i = 0; i < 32; ++i) tv[i] = src(k0 + 2 * i + (lane >> 5), n0 + (lane & 31));
#pragma unroll
    for (int i = 0; i < 32; ++i) scr[(2 * i + (lane >> 5)) * 33 + (lane & 31)] = tv[i];
    LDS_WAIT(); asm volatile("" ::: "memory");
    const int c = lane & 7;
#pragma unroll
    for (int j = 0; j < 4; ++j) { const int n = (lane >> 3) + 8 * j; const LAS float* s = scr + (8 * c) * 33 + n;
        v4u o; o.x = pk2(s[0 * 33], s[1 * 33]); o.y = pk2(s[2 * 33], s[3 * 33]); o.z = pk2(s[4 * 33], s[5 * 33]); o.w = pk2(s[6 * 33], s[7 * 33]);
        *(v4u*)(WT + (size_t)(n0 + n) * K + k0 + 8 * c) = o; }
    LDS_WAIT(); asm volatile("" ::: "memory");
}
struct SrcIn { const float* w; __device__ __forceinline__ float operator()(int k, int n) const { const int c = srccol_in(n); return c < 0 ? 0.f : w[(size_t)k * DIN + c]; } };
struct SrcQ { const float* w; const float* g; __device__ __forceinline__ float operator()(int k, int n) const { return g[k] * w[(size_t)k * 768 + srccol_q(n)]; } };
struct SrcKV { const float* w; const float* g; __device__ __forceinline__ float operator()(int k, int n) const { return g[k] * w[(size_t)k * 1024 + n]; } };
struct SrcPlain { const float* w; int N; __device__ __forceinline__ float operator()(int k, int n) const { return w[(size_t)k * N + n]; } };
struct SrcAB { const float* wa; long db; __device__ __forceinline__ float operator()(int k, int n) const { const int hi2 = k >> 9; return (wa + (long)hi2 * (db - 512 * 1024))[(size_t)k * 1024 + n]; } };
struct SrcUp { const float* wg; long du; __device__ __forceinline__ float operator()(int k, int n) const { const int f = (n >> 8) * 128 + (n & 127); return (wg + (long)((n >> 7) & 1) * du)[(size_t)k * FE + f]; } };

__device__ __forceinline__ void p0_prologue(const Frame& F0, const Ptrs& P) {
    Frame F = F0; { int t_ = threadIdx.x; asm volatile("" : "+v"(t_)); F.tid = t_; F.lane = t_ & 63; }
    LAS float* scr = (LAS float*)(F.lds + RING_OFF + F.wave * 16384);
    const int gw = F.vcu * NWAVES + F.wave, NGW = F.G * NWAVES, lane = F.lane;
    unsigned char* ws = P.ws;
    {
        const float* x = P.in[0]; const float* meta = P.in[1]; const float* g = P.in[2]; bf16* U = (bf16*)(ws + WS_U);
        f32x4 gv[4];
#pragma unroll
        for (int j = 0; j < 4; ++j) gv[j] = ((const f32x4*)g)[lane + 64 * j];
        for (int m0 = gw * 4; m0 < MROWS; m0 += NGW * 4) {
            f32x4 v[4][4];
#pragma unroll
            for (int q = 0; q < 4; ++q) { const int m = m0 + q; const f32x4* xr = (const f32x4*)(m < TR ? x + (size_t)m * DM : meta + (size_t)((m < TR + NMETA ? m : TR) - TR) * DM) + lane;
#pragma unroll
                for (int j = 0; j < 4; ++j) v[q][j] = xr[64 * j]; }
#pragma unroll
            for (int q = 0; q < 4; ++q) { const int m = m0 + q; unsigned long long* o8 = (unsigned long long*)(U + (size_t)m * DM) + lane; float s = 0.f;
#pragma unroll
                for (int j = 0; j < 4; ++j) s += (v[q][j].x * v[q][j].x + v[q][j].y * v[q][j].y) + (v[q][j].z * v[q][j].z + v[q][j].w * v[q][j].w);
                const float rstd = m < TR + NMETA ? 1.f / sqrtf(wave_sum(s) * (1.f / DM) + EPSN) : 0.f;
#pragma unroll
                for (int j = 0; j < 4; ++j) { const f32x4 w = v[q][j] * rstd * gv[j]; o8[64 * j] = (unsigned long long)pk2(w.x, w.y) | ((unsigned long long)pk2(w.z, w.w) << 32); } }
        }
    }
    {
        constexpr int I_IN = (DM / 64) * (NIN / 32), I_Q = (512 / 64) * (768 / 32), I_KV = (256 / 64) * (1024 / 32), I_AB = (512 / 64) * (1024 / 32), I_O = (1024 / 64) * (1024 / 32);
        constexpr int I_UP1 = (1024 / 64) * (512 / 32), I_UP = NEXP * I_UP1, I_D1 = (256 / 64) * (1024 / 32), I_DN = NEXP * I_D1;
        constexpr int NITEMS = I_IN + I_Q + I_KV + 2 * I_AB + I_O + I_UP + I_DN;
        for (int it = gw; it < NITEMS; it += NGW) {
            int r = it;
            if (r < I_IN) { const int nb = NIN / 32; transpose_item(SrcIn{P.in[3]}, DM, (bf16*)(ws + WS_WIN), scr, 64 * (r / nb), 32 * (r % nb), lane); continue; } r -= I_IN;
            if (r < I_Q) { const int nb = 768 / 32; transpose_item(SrcQ{P.in[6], P.in[5]}, 512, (bf16*)(ws + WS_WQUP), scr, 64 * (r / nb), 32 * (r % nb), lane); continue; } r -= I_Q;
            if (r < I_KV) { const int nb = 1024 / 32; transpose_item(SrcKV{P.in[8], P.in[7]}, 256, (bf16*)(ws + WS_WKVUP), scr, 64 * (r / nb), 32 * (r % nb), lane); continue; } r -= I_KV;
            if (r < 2 * I_AB) { const int nb = 32; transpose_item(SrcAB{P.in[9], (long)(P.in[10] - P.in[9])}, 1024, (bf16*)(ws + WS_WA), scr, 64 * (r / nb), 32 * (r % nb), lane); continue; } r -= 2 * I_AB;
            if (r < I_O) { const int nb = 32; transpose_item(SrcPlain{P.in[11], 1024}, 1024, (bf16*)(ws + WS_WOUT), scr, 64 * (r / nb), 32 * (r % nb), lane); continue; } r -= I_O;
            if (r < I_UP) { const int e = r / I_UP1, q = r % I_UP1, nb = 512 / 32;
                transpose_item(SrcUp{P.in[17] + (size_t)e * 1024 * FE, (long)(P.in[18] - P.in[17])}, 1024, (bf16*)(ws + WS_WUP) + (size_t)e * 512 * 1024, scr, 64 * (q / nb), 32 * (q % nb), lane); continue; } r -= I_UP;
            { const int e = r / I_D1, q = r % I_D1, nb = 1024 / 32;
                transpose_item(SrcPlain{P.in[19] + (size_t)e * FE * 1024, 1024}, 256, (bf16*)(ws + WS_WD) + (size_t)e * 1024 * 256, scr, 64 * (q / nb), 32 * (q % nb), lane); }
        }
    }
    {
        const int gt = F.vcu * (NWAVES * 64) + F.tid, NGT = F.G * NWAVES * 64;
        float* ct = (float*)(ws + WS_COS); float* st = (float*)(ws + WS_SIN);
        for (int i = gt; i < LSEQ * 16; i += NGT) { const int p = i >> 4, j = i & 15;
            const double ang = (double)p * pow(10000.0, -(double)j / 16.0);
            ct[i] = (float)cos(ang); st[i] = (float)sin(ang); }
        float* sq = (float*)(ws + WS_SSQQ); float* skv = (float*)(ws + WS_SSQKV);
        for (int i = gt; i < MROWS; i += NGT) { sq[i] = 0.f; skv[i] = 0.f; }
        { const float* wgr = P.in[13]; const float* wer = P.in[15]; const float* gnorm = P.in[12]; f32x4* RT = (f32x4*)(ws + WS_RTAB);
          for (int i = gt; i < 1024 + 8192; i += NGT) {
              if (i < 1024) { const int l8 = i & 7, ie = i >> 3, k = 4 * (l8 + 8 * (ie >> 2)) + (ie & 3); RT[i] = *(const f32x4*)(wgr + (size_t)k * 4) * gnorm[k]; }
              else { const int q = i - 1024, l8 = q & 7, g = (q >> 3) & 3, half = (q >> 5) & 1, ie = q >> 6, k = 4 * (l8 + 8 * (ie >> 2)) + (ie & 3); RT[i] = *(const f32x4*)(wer + (size_t)k * 32 + 8 * g + 4 * half) * gnorm[k]; } } }
        for (int i = gt; i < 16; i += NGT) ((unsigned*)(ws + WS_KNMAX))[i] = 0u;
        float* b0 = (float*)(ws + WS_BIAS0);
        for (int i = gt; i < 64; i += NGT) b0[i] = i < NMETA ? 0.f : BIG;
        for (int i = gt; i < 16 * 48 * (8 + 12 + 8 + 8); i += NGT) {
            const int per = 36, rr = i / per, c = i % per, bh = rr / 48, row = 16 + rr % 48;
            bf16* dst;
            if (c < 8) dst = (bf16*)(ws + WS_FK) + kimg_off<8>(bh, row, c);
            else if (c < 20) dst = (bf16*)(ws + WS_KM) + kimg_off<12>(bh, row, c - 8);
            else if (c < 28) dst = (bf16*)(ws + WS_FV) + vimg_off(bh, row, (c - 20) * 8);
            else dst = (bf16*)(ws + WS_VM) + vimg_off(bh, row, (c - 28) * 8);
            *(v4u*)dst = (v4u){0u, 0u, 0u, 0u}; }
    }
}

struct DenseOrder {
    int nM, nN, nwg, G, c;
    __device__ __forceinline__ void init(int nM_, int nN_, int G_, int c_) { nM = nM_; nN = nN_; nwg = nM * nN; G = G_; c = c_; }
    __device__ __forceinline__ bool next(int i, pg8::Unit& u) const {
        const long L = (long)i * G + c; if (L >= nwg) return false;
        int wgid = (int)L; { const int q = nwg / 8, r = nwg % 8, xcd = wgid % 8, off = wgid / 8; wgid = (xcd < r ? xcd * (q + 1) : r * (q + 1) + (xcd - r) * q) + off; }
        const int nig = 8 * nN, gid = wgid / nig, fm = gid * 8, gsz = (nM - fm) < 8 ? (nM - fm) : 8;
        u.pm = fm + ((wgid % nig) % gsz); u.pn = (wgid % nig) / gsz; u.be = 0; u.rbase = 0; u.rcnt = 0; return true;
    }
};
__device__ __forceinline__ int arow_of(int m) { return (m >> 13) * LP + 64 + (m & (SEQ - 1)); }
__device__ __forceinline__ float sigmoid_fast(float x) { return __builtin_amdgcn_rcpf(1.f + __builtin_amdgcn_exp2f(-LOG2E * x)); }

struct EpiP1 {
    static constexpr bool PERM = true;
    unsigned char* ws; bf16* SG;
    __device__ __forceinline__ void operator()(const pg8::f32x4 (&acc)[2][2][4][2], const pg8::Unit& u, int wr, int wc, int fr, int fq) const {
        const int pn = u.pn;
#pragma unroll
        for (int ai = 0; ai < 2; ++ai)
#pragma unroll
            for (int m = 0; m < 4; ++m) {
                const int r = u.pm * 256 + ai * 128 + wr * 64 + m * 16 + fr;
                const int c8 = wc * 32 + 8 * fq;
                if (pn < 3) {
                    float s = 0.f;
                    const size_t off = pn < 2 ? WS_CQ + ((size_t)r * 512 + pn * 256 + c8) * 2 : WS_CKV + ((size_t)r * 256 + c8) * 2;
#pragma unroll
                    for (int bj = 0; bj < 2; ++bj) { const pg8::f32x4 v0 = acc[ai][bj][m][0], v1 = acc[ai][bj][m][1];
                        s += (v0[0] * v0[0] + v0[1] * v0[1]) + (v0[2] * v0[2] + v0[3] * v0[3]) + (v1[0] * v1[0] + v1[1] * v1[1]) + (v1[2] * v1[2] + v1[3] * v1[3]);
                        *(pg8::u32x4*)(ws + off + bj * 256) = pg8::pack8(v0, v1); }
                    s += __shfl_xor(s, 16); s += __shfl_xor(s, 32);
                    if (fq == 0) atomicAdd((float*)(ws + (pn < 2 ? WS_SSQQ : WS_SSQKV)) + r, s);
                } else if (pn < 9) {
                    const int seg = (pn - 3) >> 1, cb = ((pn - 3) & 1) * 256;
                    if (r < TR + NMETA) {
                        const int b0 = r < TR ? (r >> 13) : 0, ap = r < TR ? 64 + (r & (SEQ - 1)) : r - TR;
#pragma unroll
                        for (int bj = 0; bj < 2; ++bj) { const int cc = cb + bj * 128 + c8, h = cc >> 6, d = cc & 63;
                            if (seg == 0) { const pg8::u32x4 w = pg8::pack8(acc[ai][bj][m][0] * QS_FOX, acc[ai][bj][m][1] * QS_FOX);
                                if (r < TR) *(pg8::u32x4*)(ws + WS_FQ + ((size_t)(b0 * LP + ap) * 512 + cc) * 2) = w; }
                            else { const pg8::u32x4 w = pg8::pack8(acc[ai][bj][m][0], acc[ai][bj][m][1]);
                                const size_t o = seg == 1 ? WS_FK + kimg_off<8>(b0 * 8 + h, ap, d >> 3) * 2 : WS_FV + vimg_off(b0 * 8 + h, ap, d) * 2;
                                const size_t bstep = seg == 1 ? kimg_off<8>(8, 0, 0) * 2 : vimg_off(8, 0, 0) * 2;
                                *(pg8::u32x4*)(ws + o) = w; if (r >= TR) *(pg8::u32x4*)(ws + o + bstep) = w; } }
                    }
                } else if (pn < 17) {
                    if (r < TR) {
                        bf16* base = SG + (size_t)((pn - 9) >> 2) * TR * 1024 + (size_t)r * 1024 + ((pn - 9) & 3) * 256 + c8;
#pragma unroll
                        for (int bj = 0; bj < 2; ++bj) { pg8::f32x4 v0 = acc[ai][bj][m][0], v1 = acc[ai][bj][m][1];
#pragma unroll
                            for (int e = 0; e < 4; ++e) { v0[e] = sigmoid_fast(v0[e]); v1[e] = sigmoid_fast(v1[e]); }
                            *(pg8::u32x4*)(base + bj * 128) = pg8::pack8(v0, v1); }
                    }
                } else {
                    if (c8 < 32) { float* d = (float*)(ws + WS_KR) + (size_t)r * 32 + c8; *(pg8::f32x4*)d = acc[ai][0][m][0]; *(pg8::f32x4*)(d + 4) = acc[ai][0][m][1]; }
                    else if (c8 == 32) { float* d = (float*)(ws + WS_FL) + (size_t)r * 8; *(pg8::f32x4*)d = acc[ai][0][m][0]; *(pg8::f32x4*)(d + 4) = acc[ai][0][m][1]; }
                }
            }
    }
};

struct EpiQ {
    static constexpr bool PERM = true;
    unsigned char* ws;
    __device__ __forceinline__ void operator()(const pg8::f32x4 (&acc)[2][2][4][2], const pg8::Unit& u, int wr, int wc, int fr, int fq) const {
        const float* SSQ = (const float*)(ws + WS_SSQQ); const float* ct = (const float*)(ws + WS_COS); const float* st = (const float*)(ws + WS_SIN); bf16* QM = (bf16*)(ws + WS_QM);
#pragma unroll
        for (int ai = 0; ai < 2; ++ai)
#pragma unroll
            for (int m = 0; m < 4; ++m) {
                const int r = u.pm * 256 + ai * 128 + wr * 64 + m * 16 + fr;
                const float sc = QS_MLA / sqrtf(SSQ[r] * (1.f / 512.f) + EPSN);
                const int pos = (r & (SEQ - 1)) + NMETA;
                bf16* orow = QM + (size_t)arow_of(r) * 768;
#pragma unroll
                for (int bj = 0; bj < 2; ++bj) {
                    const int c = u.pn * 256 + bj * 128 + wc * 32 + 8 * fq, d = c % 96;
                    pg8::f32x4 v0 = acc[ai][bj][m][0] * sc, v1 = acc[ai][bj][m][1] * sc;
                    if (d >= 64) {
                        const int i0 = (d - 64) >> 1;
                        const pg8::f32x4 cs = *(const pg8::f32x4*)(ct + pos * 16 + i0), sn = *(const pg8::f32x4*)(st + pos * 16 + i0);
                        pg8::f32x4 o0, o1;
                        o0[0] = v0[0] * cs[0] - v0[1] * sn[0]; o0[1] = v0[0] * sn[0] + v0[1] * cs[0];
                        o0[2] = v0[2] * cs[1] - v0[3] * sn[1]; o0[3] = v0[2] * sn[1] + v0[3] * cs[1];
                        o1[0] = v1[0] * cs[2] - v1[1] * sn[2]; o1[1] = v1[0] * sn[2] + v1[1] * cs[2];
                        o1[2] = v1[2] * cs[3] - v1[3] * sn[3]; o1[3] = v1[2] * sn[3] + v1[3] * cs[3];
                        v0 = o0; v1 = o1;
                    }
                    *(pg8::u32x4*)(orow + c) = pg8::pack8(v0, v1);
                }
            }
    }
};
struct EpiKV {
    static constexpr bool PERM = true;
    unsigned char* ws;
    __device__ __forceinline__ void operator()(const pg8::f32x4 (&acc)[2][2][4][2], const pg8::Unit& u, int wr, int wc, int fr, int fq) const {
        const float* SSKV = (const float*)(ws + WS_SSQKV);
#pragma unroll
        for (int ai = 0; ai < 2; ++ai)
#pragma unroll
            for (int m = 0; m < 4; ++m) {
                const int r = u.pm * 256 + ai * 128 + wr * 64 + m * 16 + fr;
                if (r >= TR + NMETA) continue;
                const float sc = 1.f / sqrtf(SSKV[r] * (1.f / 256.f) + EPSN);
                const int b0 = r < TR ? (r >> 13) : 0, ap = r < TR ? 64 + (r & (SEQ - 1)) : r - TR;
                const int j = wc * 32 + 8 * fq;
#pragma unroll
                for (int bj = 0; bj < 2; ++bj) {
                    const int h = u.pn * 2 + bj;
                    const pg8::u32x4 w = pg8::pack8(acc[ai][bj][m][0] * sc, acc[ai][bj][m][1] * sc);
                    const size_t o = j < 64 ? WS_KM + kimg_off<12>(b0 * 8 + h, ap, j >> 3) * 2 : WS_VM + vimg_off(b0 * 8 + h, ap, j - 64) * 2;
                    const size_t bstep = j < 64 ? kimg_off<12>(8, 0, 0) * 2 : vimg_off(8, 0, 0) * 2;
                    *(pg8::u32x4*)(ws + o) = w;
                    if (r >= TR) *(pg8::u32x4*)(ws + o + bstep) = w;
                }
            }
    }
};
__device__ __forceinline__ float log2sig(float z) {
    const float t = exp2f(-fabsf(z) * LOG2E);
    return fminf(z, 0.f) * LOG2E - log2f(1.f + t);
}
__device__ __forceinline__ void p2_small(const Frame& F0, const Ptrs& P) {
    Frame F = F0; { int t_ = threadIdx.x; asm volatile("" : "+v"(t_)); F.tid = t_; F.lane = t_ & 63; }
    unsigned char* ws = P.ws;
    {
        const int gt = F.vcu * (NWAVES * 64) + F.tid, NGT = F.G * NWAVES * 64;
        const float* KR = (const float*)(ws + WS_KR); const float* ct = (const float*)(ws + WS_COS); const float* st = (const float*)(ws + WS_SIN); bf16* KM = (bf16*)(ws + WS_KM);
        for (int i = gt; i < (TR + NMETA) * 4; i += NGT) {
            const int m = i >> 2, q = i & 3, pos = m < TR ? (m & (SEQ - 1)) + NMETA : m - TR, b0 = m < TR ? (m >> 13) : 0, ap = m < TR ? 64 + (m & (SEQ - 1)) : m - TR;
            const f32x4 v0 = *(const f32x4*)(KR + (size_t)m * 32 + q * 8), v1 = *(const f32x4*)(KR + (size_t)m * 32 + q * 8 + 4);
            const f32x4 cs = *(const f32x4*)(ct + pos * 16 + q * 4), sn = *(const f32x4*)(st + pos * 16 + q * 4);
            v4u w;
            w.x = pk2(v0[0] * cs[0] - v0[1] * sn[0], v0[0] * sn[0] + v0[1] * cs[0]); w.y = pk2(v0[2] * cs[1] - v0[3] * sn[1], v0[2] * sn[1] + v0[3] * cs[1]);
            w.z = pk2(v1[0] * cs[2] - v1[1] * sn[2], v1[0] * sn[2] + v1[1] * cs[2]); w.w = pk2(v1[2] * cs[3] - v1[3] * sn[3], v1[2] * sn[3] + v1[3] * cs[3]);
#pragma unroll
            for (int h = 0; h < 8; ++h) { bf16* d = KM + kimg_off<12>(b0 * 8 + h, ap, 8 + q); *(v4u*)d = w; if (m >= TR) *(v4u*)(d + kimg_off<12>(8, 0, 0)) = w; }
        }
    }
    {
        const bf16* FK = (const bf16*)(ws + WS_FK); unsigned* KN2 = (unsigned*)(ws + WS_KNMAX);
        const int gw = F.vcu * NWAVES + F.wave, NGW = F.G * NWAVES;
        for (int it = gw; it < 16 * NTILE; it += NGW) { const int bh = it / NTILE, r = (it % NTILE) * 64 + F.lane; float ss = 0.f;
#pragma unroll
            for (int c = 0; c < 8; ++c) { const v4u w = *(const v4u*)(FK + kimg_off<8>(bh, r, c));
#pragma unroll
                for (int e = 0; e < 4; ++e) { const float lo = __builtin_bit_cast(float, w[e] << 16), hi2 = __builtin_bit_cast(float, w[e] & 0xffff0000u); ss += lo * lo + hi2 * hi2; } }
#pragma unroll
            for (int o = 1; o < 64; o <<= 1) ss = fmaxf(ss, __shfl_xor(ss, o));
            if (F.lane == 0) atomicMax(KN2 + bh, __float_as_uint(ss)); }
    }
    if (F.vcu < NB * 8) {
        const int b = F.vcu >> 3, h = F.vcu & 7, tid = F.tid;
        const float* FL = (const float*)(ws + WS_FL); const float bfh = P.in[4][h]; float* CB = (float*)(ws + WS_CB) + (size_t)(b * 8 + h) * LP;
        LAS float* sh = (LAS float*)(F.lds + RING_OFF);
        constexpr int PER = 17;
        float v[PER]; float run = 0.f;
#pragma unroll
        for (int k = 0; k < PER; ++k) { const int p = tid * PER + k; float x = 0.f;
            if (p < LSEQ) { const int m = p < NMETA ? TR + p : b * SEQ + (p - NMETA); x = log2sig(FL[(size_t)m * 8 + h] + bfh); }
            run += x; v[k] = run; }
        float incl = run;
#pragma unroll
        for (int o = 1; o < 64; o <<= 1) { const float t = __shfl_up(incl, o); if (F.lane >= o) incl += t; }
        if (F.lane == 63) sh[F.wave] = incl;
        LDS_WAIT(); __syncthreads();
        float base = incl - run;
        for (int w = 0; w < F.wave; ++w) base += sh[w];
#pragma unroll
        for (int k = 0; k < PER; ++k) { const int p = tid * PER + k; if (p < LSEQ) CB[p < NMETA ? p : 48 + p] = base + v[k]; }
        if (tid < 48) CB[16 + tid] = BIG;
        __syncthreads();
    }
}

namespace att {
typedef short bf16x8 __attribute__((ext_vector_type(8)));
typedef short s16x4 __attribute__((ext_vector_type(4)));
typedef float f32x16 __attribute__((ext_vector_type(16)));
typedef unsigned u32x4 __attribute__((ext_vector_type(4)));
typedef float f32x2_t __attribute__((ext_vector_type(2)));
typedef __bf16 bf16x2_t __attribute__((ext_vector_type(2)));
typedef short v4i16_t __attribute__((ext_vector_type(4)));
__device__ __forceinline__ int crow(int r, int hi) { return (r & 3) + 8 * (r >> 2) + 4 * hi; }
__device__ __forceinline__ unsigned cvtpk_s(float lo, float hi) { f32x2_t v = {lo, hi}; bf16x2_t b = __builtin_convertvector(v, bf16x2_t); return __builtin_bit_cast(unsigned, b); }
__device__ __forceinline__ s16x4 vtr(LAS const char* p) { return __builtin_bit_cast(s16x4, __builtin_amdgcn_ds_read_tr16_b64_v4i16((LAS v4i16_t*)p)); }
#define ATT_MX3(a, b, c) __builtin_fmaxf(__builtin_fmaxf((a), (b)), (c))
__device__ __forceinline__ float rowmax(const f32x16& p0, const f32x16& p1) {
    float a = ATT_MX3(p0[0], p0[1], p1[0]), b = ATT_MX3(p0[2], p0[3], p1[1]); a = ATT_MX3(a, p1[2], p1[3]);
#pragma unroll
    for (int r = 4; r < 16; r += 4) { a = ATT_MX3(a, p0[r], p0[r + 1]); b = ATT_MX3(b, p0[r + 2], p0[r + 3]); a = ATT_MX3(a, p1[r], p1[r + 1]); b = ATT_MX3(b, p1[r + 2], p1[r + 3]); }
    float m = __builtin_fmaxf(a, b); auto rr = __builtin_amdgcn_permlane32_swap(__float_as_uint(m), __float_as_uint(m), false, false);
    return __builtin_fmaxf(__uint_as_float(rr[0]), __uint_as_float(rr[1])); }
__device__ __forceinline__ void cmask(f32x16& p0, f32x16& p1, int jb, int qrel, int hi) {
    const int kb = 64 * jb + 4 * hi;
#pragma unroll
    for (int r = 0; r < 16; ++r) { const int kv = kb + (r & 3) + 8 * (r >> 2); if (kv > qrel) p0[r] = -INFINITY; if (kv + 32 > qrel) p1[r] = -INFINITY; } }

template <int DK> struct Lay {
    static constexpr int KB = 64 * DK * 2;
    static constexpr int K0 = 0, V0 = 2 * KB, BI = V0 + 2 * 8192, VT = BI + 512, WS = VT + 64, OST = WS + NWAVES * 256, BYTES = OST + NWAVES * 4096;
};
struct Tens { const bf16* Q; int qp; const bf16* K; int kp; const bf16* V; const float* bias; bf16* Y; int ycol; const float* knmax; };

template <int DK, bool FOX, int THR>
__device__ __forceinline__ void attn_unit(int b, int h, int qb, const Tens T, LAS char* shm) {
    typedef Lay<DK> LY; constexpr int NDK = DK / 16;
    int tid = threadIdx.x; asm volatile("" : "+v"(tid));
    const int lane = tid & 63, r32 = lane & 31, hi = lane >> 5; const int wid = __builtin_amdgcn_readfirstlane(tid >> 6);
    const long ab = (long)b * LP; const int q0 = 64 + qb * 256, NT = 4 * qb + 5;
    const bf16* Kh = T.K + kimg_off<DK / 8>(b * 8 + h, 0, 0); const bf16* Vh = T.V + vimg_off(b * 8 + h, 0, 0);
    const float* bias = FOX ? T.bias + (size_t)(b * 8 + h) * LP : T.bias;
    LAS float* wsf = (LAS float*)(shm + LY::WS) + wid * 64;
#define ATT_DMA(t, buf) do { \
        for (int c_ = wid; c_ < DK / 8; c_ += NWAVES) \
            __builtin_amdgcn_global_load_lds((const unsigned*)(Kh + ((size_t)(t) * (DK / 8) + c_) * 512 + lane * 8), (LAS unsigned*)(shm + LY::K0 + (buf) * LY::KB + c_ * 1024), 16, 0, 0); \
        __builtin_amdgcn_global_load_lds((const unsigned*)(Vh + ((size_t)(t) * 8 + wid) * 512 + lane * 8), (LAS unsigned*)(shm + LY::V0 + (buf) * 8192 + wid * 1024), 16, 0, 0); \
    } while (0)
    const bool bias_lane = (wid == 0 && lane < 16);
    constexpr float SKIP_T = 44.f;
#define ATT_TILE(tt) (FOX ? NT - 1 - (tt) : (tt))
    f32x4 bstage = (f32x4){0.f, 0.f, 0.f, 0.f};
    ATT_DMA(ATT_TILE(0), 0);
    if (bias_lane) bstage = *(const f32x4*)(bias + 64 * ATT_TILE(0) + lane * 4);
    bf16x8 qr[NDK];
    { const bf16* Qw = T.Q + (ab + q0 + wid * 32 + r32) * T.qp + h * DK + hi * 8;
#pragma unroll
      for (int d0 = 0; d0 < NDK; ++d0) qr[d0] = *(const bf16x8*)(Qw + d0 * 16); }
    float qk_bound = 0.f;
    if (FOX) { float ss = 0.f;
#pragma unroll
        for (int d0 = 0; d0 < NDK; ++d0)
#pragma unroll
            for (int e = 0; e < 8; ++e) { const float v = __builtin_bit_cast(float, (unsigned)(unsigned short)qr[d0][e] << 16); ss += v * v; }
        auto rr = __builtin_amdgcn_permlane32_swap(__float_as_uint(ss), __float_as_uint(ss), false, false); ss = __uint_as_float(rr[0]) + __uint_as_float(rr[1]);
        qk_bound = 1.01f * sqrtf(ss * T.knmax[b * 8 + h]); }
    if (bias_lane) *(LAS f32x4*)(shm + LY::BI + lane * 16) = bstage;
    float mhat = 0.f, l_reg = 0.f; f32x16 o[2]; o[0] = f32x16{}; o[1] = f32x16{};
    const int qrel = wid * 32 + r32;
    bool first = true;
    asm volatile("s_waitcnt vmcnt(0) lgkmcnt(0)\n\ts_barrier" ::: "memory");
    for (int tt = 0; tt < NT; ++tt) {
        const int t = ATT_TILE(tt), buf = tt & 1;
        const bool more = tt + 1 < NT, nbias = more && (FOX);
        const int tn = ATT_TILE(tt + 1);
        if (more) ATT_DMA(tn, buf ^ 1);
        if (nbias && bias_lane) bstage = *(const f32x4*)(bias + 64 * tn + lane * 4);
        float cbend = 0.f; if (FOX && more) cbend = bias[tn ? 64 * tn + 63 : NMETA - 1];
        const int jb = t - (NT - 4);
        if (!(jb >= 0 && 64 * jb > 32 * wid + 31)) {
            f32x16 c0, c1; const float nm = -mhat;
            if (FOX || t == 0) {
                LAS const char* bp = shm + LY::BI + buf * 256 + hi * 16;
#pragma unroll
                for (int g = 0; g < 4; ++g) { const f32x4 b0 = *(LAS const f32x4*)(bp + g * 32), b1 = *(LAS const f32x4*)(bp + 128 + g * 32);
#pragma unroll
                    for (int e = 0; e < 4; ++e) { c0[4 * g + e] = nm - b0[e]; c1[4 * g + e] = nm - b1[e]; } }
            } else {
#pragma unroll
                for (int r = 0; r < 16; ++r) { c0[r] = nm; c1[r] = nm; }
            }
            LAS const char* kp0 = shm + LY::K0 + buf * LY::KB + hi * 1024 + r32 * 16;
#pragma unroll
            for (int d0 = 0; d0 < NDK; ++d0) {
                const bf16x8 k0 = *(LAS const bf16x8*)(kp0 + d0 * 2048), k1 = *(LAS const bf16x8*)(kp0 + d0 * 2048 + 512);
                c0 = __builtin_amdgcn_mfma_f32_32x32x16_bf16(k0, qr[d0], c0, 0, 0, 0);
                c1 = __builtin_amdgcn_mfma_f32_32x32x16_bf16(k1, qr[d0], c1, 0, 0, 0);
            }
            if (jb >= 0) cmask(c0, c1, jb, qrel, hi);
            const float rm = rowmax(c0, c1);
            if (first) {
                first = false; mhat += rm;
#pragma unroll
                for (int r = 0; r < 16; ++r) { c0[r] -= rm; c1[r] -= rm; }
            } else if (__any(rm > (float)THR)) {
                const float dl = __builtin_fmaxf(rm, 0.f); mhat += dl;
#pragma unroll
                for (int r = 0; r < 16; ++r) { c0[r] -= dl; c1[r] -= dl; }
                const float f = __builtin_amdgcn_exp2f(-dl); l_reg *= f;
                if (hi == 0) wsf[r32] = f;
                asm volatile("s_waitcnt lgkmcnt(0)" ::: "memory");
#pragma unroll
                for (int g = 0; g < 4; ++g) { const f32x4 fv = *(LAS const f32x4*)((LAS const char*)wsf + (8 * g + 4 * hi) * 4);
#pragma unroll
                    for (int e = 0; e < 4; ++e) { o[0][4 * g + e] *= fv[e]; o[1][4 * g + e] *= fv[e]; } }
            }
            float sacc = 0.f;
#pragma unroll
            for (int r = 0; r < 16; ++r) { c0[r] = __builtin_amdgcn_exp2f(c0[r]); c1[r] = __builtin_amdgcn_exp2f(c1[r]); sacc += c0[r] + c1[r]; }
            l_reg += sacc;
            u32x4 pw[4];
#pragma unroll
            for (int k = 0; k < 2; ++k)
#pragma unroll
                for (int e = 0; e < 4; ++e) { pw[k][e] = cvtpk_s(c0[8 * k + 2 * e], c0[8 * k + 2 * e + 1]); pw[2 + k][e] = cvtpk_s(c1[8 * k + 2 * e], c1[8 * k + 2 * e + 1]); }
            LAS const char* vp0 = shm + LY::V0 + buf * 8192 + ((lane >> 4) & 1) * 32 + (lane & 3) * 8 + (4 * hi + ((lane & 15) >> 2)) * 64;
#pragma unroll
            for (int d0 = 0; d0 < 2; ++d0)
#pragma unroll
                for (int ks = 0; ks < 4; ++ks) {
                    const s16x4 lo = vtr(vp0 + d0 * 4096 + ks * 1024), hh = vtr(vp0 + d0 * 4096 + ks * 1024 + 512);
                    const bf16x8 vf = (bf16x8){lo[0], lo[1], lo[2], lo[3], hh[0], hh[1], hh[2], hh[3]};
                    o[d0] = __builtin_amdgcn_mfma_f32_32x32x16_bf16(__builtin_bit_cast(bf16x8, pw[ks]), vf, o[d0], 0, 0, 0);
                }
        }
        if (nbias && bias_lane) *(LAS f32x4*)(shm + LY::BI + (buf ^ 1) * 256 + lane * 16) = bstage;
        if (FOX) {
            const bool need = first || __any(qk_bound - cbend - mhat > -SKIP_T);
            if (lane == 0) *(LAS int*)(shm + LY::VT + (buf * 8 + wid) * 4) = need ? 1 : 0;
        }
        asm volatile("s_waitcnt vmcnt(0) lgkmcnt(0)\n\ts_barrier" ::: "memory");
        if (FOX && more) {
            const f32x4 va = *(LAS const f32x4*)(shm + LY::VT + buf * 32), vb = *(LAS const f32x4*)(shm + LY::VT + buf * 32 + 16);
            const unsigned any = (__float_as_uint(va[0]) | __float_as_uint(va[1]) | __float_as_uint(va[2]) | __float_as_uint(va[3]) | __float_as_uint(vb[0]) | __float_as_uint(vb[1]) | __float_as_uint(vb[2]) | __float_as_uint(vb[3]));
            if (__builtin_amdgcn_readfirstlane(any) == 0u) break;
        }
    }
#undef ATT_TILE
    { auto rr = __builtin_amdgcn_permlane32_swap(__float_as_uint(l_reg), __float_as_uint(l_reg), false, false); l_reg = __uint_as_float(rr[0]) + __uint_as_float(rr[1]); }
    if (hi == 0) wsf[32 + r32] = l_reg;
    asm volatile("s_waitcnt lgkmcnt(0)" ::: "memory");
    float rli[16];
#pragma unroll
    for (int g = 0; g < 4; ++g) { const f32x4 lv = *(LAS const f32x4*)((LAS const char*)wsf + (32 + 8 * g + 4 * hi) * 4);
#pragma unroll
        for (int e = 0; e < 4; ++e) rli[4 * g + e] = __builtin_amdgcn_rcpf(lv[e]); }
    LAS unsigned short* stg = (LAS unsigned short*)(shm + LY::OST) + wid * 2048;
#pragma unroll
    for (int r = 0; r < 16; ++r) { const int orow = crow(r, hi);
#pragma unroll
        for (int d0 = 0; d0 < 2; ++d0) stg[orow * 64 + d0 * 32 + r32] = (unsigned short)f2bf(o[d0][r] * rli[r]); }
    asm volatile("s_waitcnt lgkmcnt(0)" ::: "memory");
    bf16* Ow = T.Y + ((size_t)b * SEQ + qb * 256 + wid * 32) * 1024 + T.ycol + h * 64;
#pragma unroll
    for (int i = 0; i < 4; ++i) { const int row = i * 8 + (lane >> 3), ch = lane & 7; const u32x4 v = *(LAS const u32x4*)(stg + row * 64 + ch * 8); *(u32x4*)(Ow + (size_t)row * 1024 + ch * 8) = v; }
    asm volatile("s_waitcnt lgkmcnt(0)\n\ts_barrier" ::: "memory");
#undef ATT_DMA
}
}

namespace att {
template <int THR>
__device__ __forceinline__ void mla_unit(int b, int h, int qb, const Tens T, LAS char* shm) {
    constexpr int DK = 96; typedef Lay<DK> LY; constexpr int NDK = 6;
    int tid = threadIdx.x; asm volatile("" : "+v"(tid));
    const int lane = tid & 63, r32 = lane & 31, hi = lane >> 5; const int wid = __builtin_amdgcn_readfirstlane(tid >> 6);
    const long ab = (long)b * LP; const int q0 = 64 + qb * 256, NT = 4 * qb + 5;
    const bf16* Kh = T.K + kimg_off<12>(b * 8 + h, 0, 0); const bf16* Vh = T.V + vimg_off(b * 8 + h, 0, 0);
    LAS float* wsf = (LAS float*)(shm + LY::WS) + wid * 64;
#define ML_DMA(t, buf) do { \
        for (int c_ = wid; c_ < 12; c_ += NWAVES) \
            __builtin_amdgcn_global_load_lds((const unsigned*)(Kh + ((size_t)(t) * 12 + c_) * 512 + lane * 8), (LAS unsigned*)(shm + LY::K0 + (buf) * LY::KB + c_ * 1024), 16, 0, 0); \
        __builtin_amdgcn_global_load_lds((const unsigned*)(Vh + ((size_t)(t) * 8 + wid) * 512 + lane * 8), (LAS unsigned*)(shm + LY::V0 + (buf) * 8192 + wid * 1024), 16, 0, 0); \
    } while (0)
#define ML_WAITBAR() asm volatile("s_waitcnt vmcnt(0) lgkmcnt(0)\n\ts_barrier" ::: "memory")
    ML_DMA(0, 0);
    { int ln = lane; asm volatile("" : "+v"(ln));
      if (wid == 0 && ln < 16) { const f32x4 bv = *(const f32x4*)(T.bias + ln * 4); *(LAS f32x4*)(shm + LY::BI + ln * 16) = bv; } }
    bf16x8 qr[NDK];
    { const bf16* Qw = T.Q + (ab + q0 + wid * 32 + r32) * T.qp + h * DK + hi * 8;
#pragma unroll
      for (int d0 = 0; d0 < NDK; ++d0) qr[d0] = *(const bf16x8*)(Qw + d0 * 16); }
    float mhat = 0.f, l_reg = 0.f; f32x16 o[2]; o[0] = f32x16{}; o[1] = f32x16{};
    const int qrel = wid * 32 + r32;
    f32x16 negm = f32x16{};
    ML_WAITBAR();
#define ML_QK(buf, c0i, c1i) do { LAS const char* kp0 = shm + LY::K0 + (buf) * LY::KB + hi * 1024 + r32 * 16; bf16x8 kf[12]; \
        _Pragma("unroll") for (int d0 = 0; d0 < NDK; ++d0) { kf[2 * d0] = *(LAS const bf16x8*)(kp0 + d0 * 2048); kf[2 * d0 + 1] = *(LAS const bf16x8*)(kp0 + d0 * 2048 + 512); } \
        __builtin_amdgcn_sched_barrier(0); \
        c0 = __builtin_amdgcn_mfma_f32_32x32x16_bf16(kf[0], qr[0], c0i, 0, 0, 0); c1 = __builtin_amdgcn_mfma_f32_32x32x16_bf16(kf[1], qr[0], c1i, 0, 0, 0); \
        _Pragma("unroll") for (int d0 = 1; d0 < NDK; ++d0) { c0 = __builtin_amdgcn_mfma_f32_32x32x16_bf16(kf[2 * d0], qr[d0], c0, 0, 0, 0); c1 = __builtin_amdgcn_mfma_f32_32x32x16_bf16(kf[2 * d0 + 1], qr[d0], c1, 0, 0, 0); } \
    } while (0)
#define ML_PV(buf) do { float sacc = 0.f; \
        _Pragma("unroll") for (int r = 0; r < 16; ++r) { c0[r] = __builtin_amdgcn_exp2f(c0[r]); c1[r] = __builtin_amdgcn_exp2f(c1[r]); sacc += c0[r] + c1[r]; } \
        l_reg += sacc; u32x4 pw[4]; \
        _Pragma("unroll") for (int k = 0; k < 2; ++k) _Pragma("unroll") for (int e = 0; e < 4; ++e) { \
            pw[k][e] = cvtpk_s(c0[8 * k + 2 * e], c0[8 * k + 2 * e + 1]); pw[2 + k][e] = cvtpk_s(c1[8 * k + 2 * e], c1[8 * k + 2 * e + 1]); } \
        LAS const char* vp0 = shm + LY::V0 + (buf) * 8192 + ((lane >> 4) & 1) * 32 + (lane & 3) * 8 + (4 * hi + ((lane & 15) >> 2)) * 64; \
        _Pragma("unroll") for (int d0 = 0; d0 < 2; ++d0) { s16x4 lo[4], hh[4]; \
            _Pragma("unroll") for (int ks = 0; ks < 4; ++ks) { lo[ks] = vtr(vp0 + d0 * 4096 + ks * 1024); hh[ks] = vtr(vp0 + d0 * 4096 + ks * 1024 + 512); } \
            __builtin_amdgcn_sched_barrier(0); \
            _Pragma("unroll") for (int ks = 0; ks < 4; ++ks) { const bf16x8 vf = (bf16x8){lo[ks][0], lo[ks][1], lo[ks][2], lo[ks][3], hh[ks][0], hh[ks][1], hh[ks][2], hh[ks][3]}; \
                o[d0] = __builtin_amdgcn_mfma_f32_32x32x16_bf16(__builtin_bit_cast(bf16x8, pw[ks]), vf, o[d0], 0, 0, 0); } } \
    } while (0)
    f32x16 c0, c1;
    {
        if (NT > 1) ML_DMA(1, 1);
        f32x16 i0, i1;
        { LAS const char* bp = shm + LY::BI + hi * 16;
#pragma unroll
          for (int g = 0; g < 4; ++g) { const f32x4 b0 = *(LAS const f32x4*)(bp + g * 32), b1 = *(LAS const f32x4*)(bp + 128 + g * 32);
#pragma unroll
              for (int e = 0; e < 4; ++e) { i0[4 * g + e] = -b0[e]; i1[4 * g + e] = -b1[e]; } } }
        ML_QK(0, i0, i1);
        const float rm = rowmax(c0, c1); mhat = rm;
#pragma unroll
        for (int r = 0; r < 16; ++r) { c0[r] -= rm; c1[r] -= rm; negm[r] = -rm; }
        ML_PV(0);
        ML_WAITBAR();
    }
    for (int t = 1; t < NT; ++t) {
        const int buf = t & 1;
        if (t + 1 < NT) ML_DMA(t + 1, buf ^ 1);
        ML_QK(buf, negm, negm);
        const int jb = t - (NT - 4);
        if (jb >= 0) cmask(c0, c1, jb, qrel, hi);
        const float rm = rowmax(c0, c1);
        const bool need = __any(rm > (float)THR);
        const float dl = need ? __builtin_fmaxf(rm, 0.f) : 0.f;
#pragma unroll
        for (int r = 0; r < 16; ++r) { c0[r] -= dl; c1[r] -= dl; }
        if (need) {
            mhat += dl;
#pragma unroll
            for (int r = 0; r < 16; ++r) negm[r] = -mhat;
            const float f = __builtin_amdgcn_exp2f(-dl); l_reg *= f;
            if (hi == 0) wsf[r32] = f;
            asm volatile("s_waitcnt lgkmcnt(0)" ::: "memory");
#pragma unroll
            for (int g = 0; g < 4; ++g) { const f32x4 fv = *(LAS const f32x4*)((LAS const char*)wsf + (8 * g + 4 * hi) * 4);
#pragma unroll
                for (int e = 0; e < 4; ++e) { o[0][4 * g + e] *= fv[e]; o[1][4 * g + e] *= fv[e]; } }
        }
        ML_PV(buf);
        ML_WAITBAR();
    }
#undef ML_DMA
#undef ML_QK
#undef ML_PV
#undef ML_WAITBAR
    { auto rr = __builtin_amdgcn_permlane32_swap(__float_as_uint(l_reg), __float_as_uint(l_reg), false, false); l_reg = __uint_as_float(rr[0]) + __uint_as_float(rr[1]); }
    if (hi == 0) wsf[32 + r32] = l_reg;
    asm volatile("s_waitcnt lgkmcnt(0)" ::: "memory");
    float rli[16];
#pragma unroll
    for (int g = 0; g < 4; ++g) { const f32x4 lv = *(LAS const f32x4*)((LAS const char*)wsf + (32 + 8 * g + 4 * hi) * 4);
#pragma unroll
        for (int e = 0; e < 4; ++e) rli[4 * g + e] = __builtin_amdgcn_rcpf(lv[e]); }
    LAS unsigned short* stg = (LAS unsigned short*)(shm + LY::OST) + wid * 2048;
#pragma unroll
    for (int r = 0; r < 16; ++r) { const int orow = crow(r, hi);
#pragma unroll
        for (int d0 = 0; d0 < 2; ++d0) stg[orow * 64 + d0 * 32 + r32] = (unsigned short)f2bf(o[d0][r] * rli[r]); }
    asm volatile("s_waitcnt lgkmcnt(0)" ::: "memory");
    bf16* Ow = T.Y + ((size_t)b * SEQ + qb * 256 + wid * 32) * 1024 + T.ycol + h * 64;
#pragma unroll
    for (int i = 0; i < 4; ++i) { const int row = i * 8 + (lane >> 3), ch = lane & 7; const u32x4 v = *(LAS const u32x4*)(stg + row * 64 + ch * 8); *(u32x4*)(Ow + (size_t)row * 1024 + ch * 8) = v; }
    asm volatile("s_waitcnt lgkmcnt(0)\n\ts_barrier" ::: "memory");
}
}


struct EpiGate {
    static constexpr bool PERM = true;
    const bf16* SGA; const bf16* SGB; bf16* MG;
    __device__ __forceinline__ void mid(pg8::f32x4 (&acc)[2][2][4][2], const pg8::Unit& u, int wr, int wc, int fr, int fq) const {
        asm volatile("" : "+v"(fr), "+v"(fq));
#pragma unroll
        for (int ai = 0; ai < 2; ++ai)
#pragma unroll
            for (int m = 0; m < 4; ++m) {
                const int r = u.pm * 256 + ai * 128 + wr * 64 + m * 16 + fr;
#pragma unroll
                for (int bj = 0; bj < 2; ++bj) {
                    const size_t off = (size_t)r * 1024 + u.pn * 256 + bj * 128 + wc * 32 + 8 * fq;
                    const pg8::u32x4 sa = *(const pg8::u32x4*)(SGA + off), sb = *(const pg8::u32x4*)(SGB + off);
#pragma unroll
                    for (int e = 0; e < 4; ++e) {
                        const float a0 = __builtin_bit_cast(float, sa[e] << 16), a1 = __builtin_bit_cast(float, sa[e] & 0xffff0000u);
                        const float b0 = __builtin_bit_cast(float, sb[e] << 16), b1 = __builtin_bit_cast(float, sb[e] & 0xffff0000u);
                        const float r0 = a0 * __builtin_amdgcn_rcpf(__builtin_fmaxf(b0, 1e-30f)), r1 = a1 * __builtin_amdgcn_rcpf(__builtin_fmaxf(b1, 1e-30f));
                        if (e < 2) { acc[ai][bj][m][0][2 * e] *= r0; acc[ai][bj][m][0][2 * e + 1] *= r1; } else { acc[ai][bj][m][1][2 * (e - 2)] *= r0; acc[ai][bj][m][1][2 * (e - 2) + 1] *= r1; }
                    }
                    asm volatile("" : "+v"(acc[ai][bj][m][0]), "+v"(acc[ai][bj][m][1]) :: "memory");
                }
            }
    }
    __device__ __forceinline__ void operator()(const pg8::f32x4 (&acc)[2][2][4][2], const pg8::Unit& u, int wr, int wc, int fr, int fq) const {
#pragma unroll
        for (int ai = 0; ai < 2; ++ai)
#pragma unroll
            for (int m = 0; m < 4; ++m) {
                const int r = u.pm * 256 + ai * 128 + wr * 64 + m * 16 + fr;
#pragma unroll
                for (int bj = 0; bj < 2; ++bj) {
                    const size_t off = (size_t)r * 1024 + u.pn * 256 + bj * 128 + wc * 32 + 8 * fq;
                    const pg8::u32x4 sb = *(const pg8::u32x4*)(SGB + off);
                    pg8::f32x4 v0 = acc[ai][bj][m][0], v1 = acc[ai][bj][m][1];
#pragma unroll
                    for (int e = 0; e < 2; ++e) { v0[2 * e] *= __builtin_bit_cast(float, sb[e] << 16); v0[2 * e + 1] *= __builtin_bit_cast(float, sb[e] & 0xffff0000u);
                                                  v1[2 * e] *= __builtin_bit_cast(float, sb[2 + e] << 16); v1[2 * e + 1] *= __builtin_bit_cast(float, sb[2 + e] & 0xffff0000u); }
                    *(pg8::u32x4*)(MG + off) = pg8::pack8(v0, v1);
                }
            }
    }
};
struct EpiRes {
    static constexpr bool PERM = false;
    const float* X; float* H1;
    __device__ __forceinline__ void operator()(const pg8::f32x4 (&acc)[2][2][4][2], const pg8::Unit& u, int wr, int wc, int fr, int fq) const {
#pragma unroll
        for (int ai = 0; ai < 2; ++ai)
#pragma unroll
            for (int m = 0; m < 4; ++m) {
                const size_t ro = (size_t)(u.pm * 256 + ai * 128 + wr * 64 + m * 16 + fr) * 1024 + u.pn * 256 + wc * 32 + 4 * fq;
#pragma unroll
                for (int bj = 0; bj < 2; ++bj)
#pragma unroll
                    for (int n = 0; n < 2; ++n) { const size_t off = ro + bj * 128 + n * 16; *(pg8::f32x4*)(H1 + off) = *(const pg8::f32x4*)(X + off) + acc[ai][bj][m][n]; }
            }
    }
};

constexpr size_t RT_TOKPOS = WS_RT;
constexpr size_t RT_LIST = WS_U, RT_LISTW = WS_U + 2 * MiB;
constexpr int CW_TOT = 3072;
constexpr int ECAP = 16384;
constexpr int MAXSLOT = 40960;
constexpr int RTAB_BYTES = 147456, P6_SCR = RTAB_BYTES;
__device__ __forceinline__ float red8(float v) { v += __shfl_xor(v, 1); v += __shfl_xor(v, 2); v += __shfl_xor(v, 4); return v; }
__device__ __forceinline__ void p6a_route(const Frame& F0, const Ptrs& P) {
    Frame F = F0; { int t_ = threadIdx.x; asm volatile("" : "+v"(t_)); F.tid = t_; F.lane = t_ & 63; }
    unsigned char* ws = P.ws; const int lane = F.lane, tid = F.tid, li = lane & 7, tk = lane >> 3;
    LAS f32x4* RTg = (LAS f32x4*)(F.lds);
    LAS f32x4* RTe = (LAS f32x4*)(F.lds + 16384);
    LAS int* eid = (LAS int*)(F.lds + P6_SCR);
    const float* gnorm = P.in[12];
    { const unsigned char* src = ws + WS_RTAB;
      for (int p = F.wave; p < 144; p += NWAVES) __builtin_amdgcn_global_load_lds((const unsigned*)(src + p * 1024 + lane * 16), (LAS unsigned*)(F.lds + p * 1024), 16, 0, 0); }
    float bg[4];
#pragma unroll
    for (int c = 0; c < 4; ++c) bg[c] = P.in[14][c];
    VM_WAIT(); LDS_WAIT(); __syncthreads();
    const float* H1 = P.out; bf16* T = (bf16*)(ws + WS_T);
    int* LIST = (int*)(ws + RT_LIST); float* LISTW = (float*)(ws + RT_LISTW); int* TOKPOS = (int*)(ws + RT_TOKPOS);
    for (int v = F.vcu; v < 256; v += F.G) {
        const int tl = F.wave * 8 + tk, tok = v * 64 + tl;
        const f32x4* hr = (const f32x4*)(H1 + (size_t)tok * DM) + li;
        f32x4 hv[32];
#pragma unroll
        for (int i = 0; i < 32; ++i) hv[i] = hr[8 * i];
        float ss = 0.f; f32x4 a4 = (f32x4){0.f, 0.f, 0.f, 0.f};
#pragma unroll
        for (int i = 0; i < 32; ++i) { ss += (hv[i].x * hv[i].x + hv[i].y * hv[i].y) + (hv[i].z * hv[i].z + hv[i].w * hv[i].w);
#pragma unroll
            for (int e = 0; e < 4; ++e) a4 += RTg[(i * 4 + e) * 8 + li] * hv[i][e]; }
        const float rstd = 1.f / sqrtf(red8(ss) * (1.f / DM) + EPSN);
        float gl[4];
#pragma unroll
        for (int c = 0; c < 4; ++c) gl[c] = red8(a4[c]) * rstd + bg[c];
        int g = 0; float gm = gl[0];
#pragma unroll
        for (int c = 1; c < 4; ++c) if (gl[c] > gm) { gm = gl[c]; g = c; }
        float gs = 0.f;
#pragma unroll
        for (int c = 0; c < 4; ++c) gs += expf(gl[c] - gm);
        const float gw = 1.f / gs;
        f32x4 e0 = (f32x4){0.f, 0.f, 0.f, 0.f}, e1 = e0;
        unsigned long long* o8 = (unsigned long long*)(T + (size_t)tok * DM) + li;
        const f32x4* gp = (const f32x4*)gnorm + li;
        LAS const f32x4* rte = RTe + g * 8 + li;
#pragma unroll
        for (int i = 0; i < 32; ++i) { const f32x4 tv = hv[i] * rstd * gp[8 * i];
            o8[8 * i] = (unsigned long long)pk2(tv.x, tv.y) | ((unsigned long long)pk2(tv.z, tv.w) << 32);
#pragma unroll
            for (int e = 0; e < 4; ++e) { e0 += rte[((i * 4 + e) * 2) * 32] * hv[i][e]; e1 += rte[((i * 4 + e) * 2 + 1) * 32] * hv[i][e]; } }
        float el[8];
#pragma unroll
        for (int c = 0; c < 4; ++c) { el[c] = red8(e0[c]) * rstd + P.in[16][g * 8 + c]; el[4 + c] = red8(e1[c]) * rstd + P.in[16][g * 8 + 4 + c]; }
        int i0 = 0; float v0 = el[0];
#pragma unroll
        for (int c = 1; c < 8; ++c) if (el[c] > v0) { v0 = el[c]; i0 = c; }
        int i1 = -1; float v1 = -INFINITY;
#pragma unroll
        for (int c = 0; c < 8; ++c) if (c != i0 && el[c] > v1) { v1 = el[c]; i1 = c; }
        const float p1 = expf(v1 - v0), w0 = gw / (1.f + p1), w1 = gw * p1 / (1.f + p1);
        if (li == 0) { eid[tl * 2] = g * 8 + i0; eid[tl * 2 + 1] = g * 8 + i1; ((LAS float*)(eid + 128))[tl * 2] = w0; ((LAS float*)(eid + 128))[tl * 2 + 1] = w1; }
        LDS_WAIT(); __syncthreads();
        LAS int* eoff = eid + 256;
        if (tid < 32) { int c = 0; for (int j = 0; j < 128; ++j) c += (eid[j] == tid) ? 1 : 0; eoff[tid] = c ? (int)atomicAdd(F.ctl + CW_TOT + tid, (unsigned)c) : 0; }
        LDS_WAIT(); __syncthreads();
        if (tid < 128) { const int a = tid, me = eid[a]; int r = 0; for (int j = 0; j < a; ++j) r += (eid[j] == me) ? 1 : 0;
            const int pos = eoff[me] + r; LIST[me * ECAP + pos] = v * 64 + (a >> 1); LISTW[me * ECAP + pos] = ((LAS float*)(eid + 128))[a]; TOKPOS[(v * 64) * 2 + a] = me * ECAP + pos; }
        __syncthreads();
    }
}
__device__ __forceinline__ LAS int* moe_tiles(const Frame& F0) {
    Frame F = F0; { int t_ = threadIdx.x; asm volatile("" : "+v"(t_)); F.tid = t_; F.lane = t_ & 63; }
    LAS int* tb = (LAS int*)(F.lds + LDSCTL_OFF + 512);
    if (F.tid == 0) { int b = 0; for (int e = 0; e < 32; ++e) { tb[e] = b; b += ((int)__hip_atomic_load(F.ctl + CW_TOT + e, __ATOMIC_RELAXED, __HIP_MEMORY_SCOPE_AGENT) + 255) >> 8; } tb[32] = b; }
    LDS_WAIT(); __syncthreads();
    return tb;
}
struct MoeOrder {
    LAS const int* tb; const unsigned* tot; int nc, G, c;
    __device__ __forceinline__ bool next(int i, pg8::Unit& u) const {
        const int L = i * G + c; if (L >= tb[32] * nc) return false;
        u.pm = L / nc; u.pn = L % nc; int e = 0;
#pragma unroll 1
        for (int j = 1; j < 32; ++j) e += (tb[j] <= u.pm) ? 1 : 0;
        u.be = e; const int lt = u.pm - tb[e], n = (int)tot[e] - lt * 256; u.rbase = e * ECAP + lt * 256; u.rcnt = n < 256 ? n : 256; return true; }
};
struct EpiUp {
    static constexpr bool PERM = true;
    const float* ROWW; bf16* HM;
    __device__ __forceinline__ void operator()(const pg8::f32x4 (&acc)[2][2][4][2], const pg8::Unit& u, int wr, int wc, int fr, int fq) const {
#pragma unroll
        for (int ai = 0; ai < 2; ++ai)
#pragma unroll
            for (int m = 0; m < 4; ++m) {
                const int lr = ai * 128 + wr * 64 + m * 16 + fr, r = u.pm * 256 + lr; const float cw = lr < u.rcnt ? ROWW[u.rbase + lr] : 0.f;
                pg8::f32x4 o[2];
#pragma unroll
                for (int n = 0; n < 2; ++n)
#pragma unroll
                    for (int e = 0; e < 4; ++e) { const float a = acc[ai][0][m][n][e], b = acc[ai][1][m][n][e]; o[n][e] = a * sigmoid_fast(a) * b * cw; }
                *(pg8::u32x4*)(HM + (size_t)r * FE + u.pn * 128 + wc * 32 + 8 * fq) = pg8::pack8(o[0], o[1]);
            }
    }
};
struct EpiDown {
    static constexpr bool PERM = true;
    bf16* YE;
    __device__ __forceinline__ void operator()(const pg8::f32x4 (&acc)[2][2][4][2], const pg8::Unit& u, int wr, int wc, int fr, int fq) const {
#pragma unroll
        for (int ai = 0; ai < 2; ++ai)
#pragma unroll
            for (int m = 0; m < 4; ++m) {
                const size_t ro = (size_t)(u.pm * 256 + ai * 128 + wr * 64 + m * 16 + fr) * 1024 + u.pn * 256 + wc * 32 + 8 * fq;
#pragma unroll
                for (int bj = 0; bj < 2; ++bj) *(pg8::u32x4*)(YE + ro + bj * 128) = pg8::pack8(acc[ai][bj][m][0], acc[ai][bj][m][1]);
            }
    }
};
__device__ __forceinline__ void p9_final(const Frame& F0, const Ptrs& P) {
    Frame F = F0; { int t_ = threadIdx.x; asm volatile("" : "+v"(t_)); F.tid = t_; F.lane = t_ & 63; }
    unsigned char* ws = P.ws; const int lane = F.lane; const int gw = F.vcu * NWAVES + F.wave, NGW = F.G * NWAVES;
    const int* TOKPOS = (const int*)(ws + RT_TOKPOS); const bf16* YE = (const bf16*)(ws + WS_YE); LAS const int* tb = moe_tiles(F);
    f32x4 gn[4];
#pragma unroll
    for (int j = 0; j < 4; ++j) gn[j] = ((const f32x4*)P.in[20])[lane + 64 * j];
    for (int tok = gw; tok < TR; tok += NGW) {
        const int c0 = TOKPOS[tok * 2], c1 = TOKPOS[tok * 2 + 1]; const int s0 = tb[c0 >> 14] * 256 + (c0 & (ECAP - 1)), s1 = tb[c1 >> 14] * 256 + (c1 & (ECAP - 1));
        f32x4* hr = (f32x4*)(P.out + (size_t)tok * DM) + lane;
        const unsigned long long* y0 = (const unsigned long long*)(YE + (size_t)s0 * DM) + lane; const unsigned long long* y1 = (const unsigned long long*)(YE + (size_t)s1 * DM) + lane;
        f32x4 v[4]; float ss = 0.f;
#pragma unroll
        for (int j = 0; j < 4; ++j) { v[j] = hr[64 * j]; const unsigned long long a = y0[64 * j], b = y1[64 * j];
            v[j].x += bf2f((unsigned short)a) + bf2f((unsigned short)b); v[j].y += bf2f((unsigned short)(a >> 16)) + bf2f((unsigned short)(b >> 16));
            v[j].z += bf2f((unsigned short)(a >> 32)) + bf2f((unsigned short)(b >> 32)); v[j].w += bf2f((unsigned short)(a >> 48)) + bf2f((unsigned short)(b >> 48));
            ss += (v[j].x * v[j].x + v[j].y * v[j].y) + (v[j].z * v[j].z + v[j].w * v[j].w); }
        const float rstd = 1.f / sqrtf(wave_sum(ss) * (1.f / DM) + EPSN);
#pragma unroll
        for (int j = 0; j < 4; ++j) hr[64 * j] = v[j] * rstd * gn[j];
    }
}

#ifndef REP_PHASE
#define REP_PHASE (-1)
#endif
#ifndef REP_ATT
#define REP_ATT 3
#endif
__global__ void __launch_bounds__(NWAVES * 64, 2) mega(Ptrs P) {
    extern __shared__ __attribute__((aligned(16))) unsigned char lds_raw[];
    Frame F;
    F.lds = (LAS unsigned char*)lds_raw;
    F.MISC = (volatile LAS unsigned*)(F.lds + MISC_OFF);
    F.tid = threadIdx.x; F.lane = F.tid & 63; F.wave = __builtin_amdgcn_readfirstlane(F.tid >> 6);
    F.G = gridDim.x; { const int bx = blockIdx.x; F.vcu = (F.G % 8 == 0) ? (bx % 8) * (F.G / 8) + bx / 8 : bx; }
    unsigned char* ws = P.ws;
    F.ctl = (unsigned*)(ws + WS_CTL);
    for (int u = F.tid; u < (LDS_BYTES - LDSCTL_OFF) / 4; u += NWAVES * 64) ((LAS unsigned*)(F.lds + LDSCTL_OFF))[u] = 0u;
    __syncthreads();
    const int lo = P.ph_lo, hi = P.ph_hi;
    XcdBarrier bar; bar.bar = F.ctl + CW_BAR; bar.x = 0; bar.st = nullptr;
    if (hi - lo > 1) bar = xcd_barrier_post(F.ctl + CW_BAR, F.MISC + 8);
#define IN(k) (lo <= (k) && (k) < hi)
#define SEAM(k) do { if (IN(k) && IN((k) + 1)) xcd_barrier(bar); } while (0)
#define RUN(k, BODY) do { if (IN(k)) { BODY; if (REP_PHASE == (k)) { xcd_barrier(bar); BODY; } } SEAM(k); } while (0)

#define PH0 do { p0_prologue(F, P); } while (0)
#define PH1 do { pg8::Gemm g{(const bf16*)(ws + WS_U), (const bf16*)(ws + WS_WIN), DM, DM, nullptr, 0}; \
        DenseOrder S; S.init(MROWS / 256, NIN / 256, F.G, (int)blockIdx.x); EpiP1 E{ws, (bf16*)P.out}; \
        pg8::gemm_phase<EpiP1, DenseOrder, true>(F.lds + RING_OFF, g, S, E); } while (0)
#define PH2 do { \
        { pg8::Gemm g{(const bf16*)(ws + WS_CQ), (const bf16*)(ws + WS_WQUP), 512, 512, nullptr, 0}; DenseOrder S; S.init(TR / 256, 3, F.G, (int)blockIdx.x); \
          EpiQ E{ws}; pg8::gemm_phase<EpiQ, DenseOrder, true>(F.lds + RING_OFF, g, S, E); } \
        { pg8::Gemm g{(const bf16*)(ws + WS_CKV), (const bf16*)(ws + WS_WKVUP), 256, 256, nullptr, 0}; DenseOrder S; S.init(MROWS / 256, 4, F.G, (int)blockIdx.x); \
          EpiKV E{ws}; pg8::gemm_phase<EpiKV, DenseOrder, true>(F.lds + RING_OFF, g, S, E); } \
        p2_small(F, P); } while (0)
#define PH3X(DOM, DOF) do { \
        const att::Tens TM{(const bf16*)(ws + WS_QM), 768, (const bf16*)(ws + WS_KM), 768, (const bf16*)(ws + WS_VM), (const float*)(ws + WS_BIAS0), (bf16*)(ws + WS_Y), 0, nullptr}; \
        const att::Tens TF{(const bf16*)(ws + WS_FQ), 512, (const bf16*)(ws + WS_FK), 512, (const bf16*)(ws + WS_FV), (const float*)(ws + WS_CB), (bf16*)(ws + WS_Y), 512, (const float*)(ws + WS_KNMAX)}; \
        LAS char* shm = (LAS char*)(F.lds + RING_OFF); \
        for (int v = F.vcu; v < 256; v += F.G) { \
            const int bh = v >> 4, s = v & 15, b = bh >> 3, h = bh & 7; \
            if (DOM) att::mla_unit<8>(b, h, 31 - s, TM, shm); \
            if (DOF) att::attn_unit<64, true, 8>(b, h, 31 - s, TF, shm); \
            if (DOM) att::mla_unit<8>(b, h, s, TM, shm); \
            if (DOF) att::attn_unit<64, true, 8>(b, h, s, TF, shm); \
        } } while (0)
#define PH4 do { DenseOrder S; S.init(TR / 256, 4, F.G, (int)blockIdx.x); \
        pg8::Gemm g{(const bf16*)(ws + WS_Y), (const bf16*)(ws + WS_WA), 1024, 1024, nullptr, 0}; \
        EpiGate E{(const bf16*)P.out, (const bf16*)P.out + (size_t)TR * 1024, (bf16*)(ws + WS_MERGED)}; pg8::gemm_phase<EpiGate, DenseOrder, true, true>(F.lds + RING_OFF, g, S, E); } while (0)
#define PH5 do { DenseOrder S; S.init(TR / 256, 4, F.G, (int)blockIdx.x); \
        pg8::Gemm g{(const bf16*)(ws + WS_MERGED), (const bf16*)(ws + WS_WOUT), 1024, 1024, nullptr, 0}; \
        EpiRes E{P.in[0], P.out}; pg8::gemm_phase<EpiRes, DenseOrder, true>(F.lds + RING_OFF, g, S, E); } while (0)
#define PH6 do { p6a_route(F, P); } while (0)
#define PH8 do { LAS const int* tb = moe_tiles(F); MoeOrder S{tb, F.ctl + CW_TOT, 2, F.G, F.vcu}; \
        pg8::Gemm g{(const bf16*)(ws + WS_T), (const bf16*)(ws + WS_WUP), 1024, 1024, (const int*)(ws + RT_LIST), (size_t)512 * 1024 * 2}; \
        EpiUp E{(const float*)(ws + RT_LISTW), (bf16*)(ws + WS_HM)}; pg8::gemm_phase<EpiUp, MoeOrder, true>(F.lds + RING_OFF, g, S, E); } while (0)
#define PH9 do { LAS const int* tb = moe_tiles(F); MoeOrder S{tb, F.ctl + CW_TOT, 4, F.G, F.vcu}; \
        pg8::Gemm g{(const bf16*)(ws + WS_HM), (const bf16*)(ws + WS_WD), 256, 256, nullptr, (size_t)1024 * 256 * 2}; \
        EpiDown E{(bf16*)(ws + WS_YE)}; pg8::gemm_phase<EpiDown, MoeOrder, true>(F.lds + RING_OFF, g, S, E); } while (0)

    RUN(0, PH0);
    if (IN(1)) { PH1; if (REP_PHASE == 1) { xcd_barrier(bar); for (int i = F.vcu * 512 + F.tid; i < MROWS; i += F.G * 512) { ((float*)(ws + WS_SSQQ))[i] = 0.f; ((float*)(ws + WS_SSQKV))[i] = 0.f; } xcd_barrier(bar); PH1; } } SEAM(1);
    RUN(2, PH2);
    if (IN(3)) { PH3X(true, true); if (REP_PHASE == 3) { xcd_barrier(bar); PH3X((REP_ATT & 1) != 0, (REP_ATT & 2) != 0); } } SEAM(3);
    RUN(4, PH4);
    RUN(5, PH5);
    RUN(6, PH6);
    RUN(7, PH8);
    RUN(8, PH9);
    if (IN(9)) { p9_final(F, P); }
#undef IN
#undef SEAM
#undef RUN
}

extern "C" void kernel_launch(void* const* d_in, const int* in_sizes, int n_in, void* d_out, int out_size, void* d_ws, size_t ws_size, hipStream_t stream) {
    static int grid = 0;
    if (grid == 0) {
        if (n_in != 21 || out_size != TR * DM || ws_size < WS_END) { fprintf(stderr, "kernel_launch: unexpected shapes (n_in %d, out %d, ws %zu)\n", n_in, out_size, ws_size); grid = -1; return; }
        int dev = 0, cus = 0;
        if (hipGetDevice(&dev) != hipSuccess || hipDeviceGetAttribute(&cus, hipDeviceAttributeMultiprocessorCount, dev) != hipSuccess) { grid = -1; return; }
        if (hipFuncSetAttribute((const void*)mega, hipFuncAttributeMaxDynamicSharedMemorySize, LDS_BYTES) != hipSuccess) { fprintf(stderr, "kernel_launch: hipFuncSetAttribute failed\n"); grid = -1; return; }
        int per_cu = 0; (void)hipOccupancyMaxActiveBlocksPerMultiprocessor(&per_cu, (const void*)mega, NWAVES * 64, LDS_BYTES); (void)hipGetLastError();
        grid = cus;
    }
    if (grid < 0) return;
    (void)hipMemsetAsync((char*)d_ws + WS_CTL, 0, CTL_ZERO_BYTES, stream);
    Ptrs p{};
    for (int i = 0; i < 21; ++i) p.in[i] = (const float*)d_in[i];
    p.out = (float*)d_out; p.ws = (unsigned char*)d_ws;
    p.ph_lo = 0; p.ph_hi = 10;
    hipLaunchKernelGGL(mega, dim3(grid), dim3(NWAVES * 64), LDS_BYTES, stream, p);

}
```
